# Optimizing an MI355X kernel written in HIP

```python
import jax, jax.numpy as jnp
from jax import lax
import numpy as np

D_MODEL = 1024
BATCH = 16
SEQ = 2048
DEPTH = 1

PLE_DIM = 256
D_MIX = D_MODEL
CONV_CH = D_MIX // 2
CONV_GROUPS = 8
CONV_WIDTH = 31
ATTN_WIDTH = D_MIX - CONV_CH
HEAD_DIM = 64
N_HEADS = ATTN_WIDTH // HEAD_DIM
ROT_DIM = HEAD_DIM // 4
ROPE_THETA = 500000.0
MOBA_BLOCK = 256
MOBA_TOPK = 3
Q_CHUNK = 16
N_GROUPS = 4
EXPERTS_PER_GROUP = 8
N_EXPERTS = N_GROUPS * EXPERTS_PER_GROUP
TOPK_IN_GROUP = 2
D_EXPERT = D_MODEL // 4
IN_COLS = 2 * CONV_CH + 3 * ATTN_WIDTH
EPS = 1e-6

kernel_name = 'hymba_conformer_moba_hmoe_block'


def rms_norm(x, g):
    xf = x.astype(jnp.float32)
    y = xf * lax.rsqrt(jnp.mean(xf * xf, axis=-1, keepdims=True) + EPS)
    return (y * g.astype(jnp.float32)).astype(x.dtype)


def layer_norm(x, g, b):
    xf = x.astype(jnp.float32)
    mu = jnp.mean(xf, axis=-1, keepdims=True)
    var = jnp.mean(jnp.square(xf - mu), axis=-1, keepdims=True)
    y = (xf - mu) * lax.rsqrt(var + EPS) * g.astype(jnp.float32) + b.astype(jnp.float32)
    return y.astype(x.dtype)


def rope_tables(seq):
    pos = jnp.arange(seq, dtype=jnp.float32)
    inv_freq = jnp.power(jnp.float32(ROPE_THETA), -jnp.arange(0, ROT_DIM, 2, dtype=jnp.float32) / ROT_DIM)
    ang = pos[:, None] * inv_freq[None, :]
    return jnp.cos(ang), jnp.sin(ang)


def partial_rope(t, cos, sin):
    half = ROT_DIM // 2
    tf = t.astype(jnp.float32)
    t1 = tf[..., :half]
    t2 = tf[..., half:ROT_DIM]
    out = jnp.concatenate([t1 * cos - t2 * sin, t2 * cos + t1 * sin, tf[..., ROT_DIM:]], axis=-1)
    return out.astype(t.dtype)


def conformer_conv(a, gate, w_dw, b_dw, ln_g, ln_b):
    u = a * jax.nn.sigmoid(gate)
    kern = w_dw[:, None, :].astype(u.dtype)
    y = lax.conv_general_dilated(u, kern, window_strides=(1,), padding=[(CONV_WIDTH - 1, 0)],
                                 dimension_numbers=('NWC', 'WIO', 'NWC'),
                                 feature_group_count=CONV_CH)
    y = y + b_dw.astype(y.dtype)
    y = layer_norm(y, ln_g, ln_b)
    return jax.nn.silu(y)


def moba_attention(q, k, v):
    B, H, S, dh = q.shape
    nb = -(-S // MOBA_BLOCK)
    s_pad = nb * MOBA_BLOCK
    pad = s_pad - S
    padw = ((0, 0), (0, 0), (0, pad), (0, 0))
    qp, kp, vp = jnp.pad(q, padw), jnp.pad(k, padw), jnp.pad(v, padw)
    kb = kp.reshape(B, H, nb, MOBA_BLOCK, dh)
    vb = vp.reshape(B, H, nb, MOBA_BLOCK, dh)
    neg = jnp.finfo(jnp.float32).min

    k_mean = jnp.mean(kb.astype(jnp.float32), axis=3)
    q_blk = jnp.arange(s_pad) // MOBA_BLOCK
    gate = jnp.einsum('bhsd,bhnd->bhsn', qp.astype(jnp.float32), k_mean)
    past = jnp.arange(nb)[None, :] < q_blk[:, None]
    gate = jnp.where(past, gate, neg)
    n_sel = min(MOBA_TOPK, nb)
    _, sel = lax.top_k(gate, n_sel)
    sel_valid = sel < q_blk[:, None]

    n_chunks = s_pad // Q_CHUNK
    q_c = jnp.moveaxis(qp.reshape(B, H, n_chunks, Q_CHUNK, dh), 2, 0)
    sel_c = jnp.moveaxis(sel.reshape(B, H, n_chunks, Q_CHUNK, n_sel), 2, 0)
    val_c = jnp.moveaxis(sel_valid.reshape(B, H, n_chunks, Q_CHUNK, n_sel), 2, 0)
    scale = HEAD_DIM ** -0.5
    gather_blocks = jax.vmap(jax.vmap(lambda blocks, idx: blocks[idx]))
    q_off = jnp.arange(Q_CHUNK)
    k_off = jnp.arange(MOBA_BLOCK)

    def attend_chunk(args):
        c, qc, selc, validc = args
        start = c * Q_CHUNK
        blk = start // MOBA_BLOCK
        in_blk = start % MOBA_BLOCK + q_off
        k_sel = gather_blocks(kb, selc).astype(jnp.float32)
        v_sel = gather_blocks(vb, selc).astype(jnp.float32)
        k_own = lax.dynamic_index_in_dim(kb, blk, axis=2, keepdims=False).astype(jnp.float32)
        v_own = lax.dynamic_index_in_dim(vb, blk, axis=2, keepdims=False).astype(jnp.float32)
        qf = qc.astype(jnp.float32) * scale
        s_sel = jnp.einsum('bhqd,bhqnkd->bhqnk', qf, k_sel)
        s_sel = jnp.where(validc[..., None], s_sel, neg).reshape(B, H, Q_CHUNK, n_sel * MOBA_BLOCK)
        s_own = jnp.einsum('bhqd,bhkd->bhqk', qf, k_own)
        s_own = jnp.where(k_off[None, :] <= in_blk[:, None], s_own, neg)
        probs = jax.nn.softmax(jnp.concatenate([s_sel, s_own], axis=-1), axis=-1)
        p_sel = probs[..., :n_sel * MOBA_BLOCK].reshape(B, H, Q_CHUNK, n_sel, MOBA_BLOCK)
        p_own = probs[..., n_sel * MOBA_BLOCK:]
        out = (jnp.einsum('bhqnk,bhqnkd->bhqd', p_sel, v_sel)
               + jnp.einsum('bhqk,bhkd->bhqd', p_own, v_own))
        return out.astype(qc.dtype)

    out = lax.map(attend_chunk, (jnp.arange(n_chunks), q_c, sel_c, val_c))
    out = jnp.moveaxis(out, 0, 2).reshape(B, H, s_pad, dh)
    return out[:, :, :S]


def hier_moe(h, w_group, b_group, w_erouter, b_erouter, w_gate, w_up, w_down):
    hf = h.astype(jnp.float32)
    g_logits = hf @ w_group.astype(jnp.float32) + b_group.astype(jnp.float32)
    g_probs = jax.nn.softmax(g_logits, axis=-1)
    g_idx = jnp.argmax(g_logits, axis=-1)
    g_w = jnp.take_along_axis(g_probs, g_idx[..., None], axis=-1)
    e_all = jnp.einsum('bsd,gde->bsge', hf, w_erouter.astype(jnp.float32)) + b_erouter.astype(jnp.float32)
    e_logits = jnp.take_along_axis(e_all, g_idx[..., None, None], axis=2)[:, :, 0]
    top_vals, top_idx = lax.top_k(e_logits, TOPK_IN_GROUP)
    top_w = jax.nn.softmax(top_vals, axis=-1) * g_w
    expert_id = g_idx[..., None] * EXPERTS_PER_GROUP + top_idx
    gates = jnp.sum(jax.nn.one_hot(expert_id, N_EXPERTS, dtype=jnp.float32) * top_w[..., None], axis=-2)
    y = jnp.zeros(h.shape, jnp.float32)
    for e in range(N_EXPERTS):
        hid = jax.nn.silu(h @ w_gate[e]) * (h @ w_up[e])
        y = y + gates[..., e:e + 1] * (hid @ w_down[e]).astype(jnp.float32)
    return y.astype(h.dtype)


def setup_inputs(seed: int = 0) -> dict:
    key = jax.random.key(seed)
    ks = jax.random.split(key, 24)
    f32 = jnp.float32
    nrm = lambda k, shape, s: jax.random.normal(k, shape, f32) * s
    L = DEPTH
    return {
        'x': nrm(ks[0], (BATCH, SEQ, D_MODEL), 1.0),
        'p': nrm(ks[1], (DEPTH, BATCH, SEQ, PLE_DIM), 1.0),
        'g_mix': 1.0 + nrm(ks[2], (L, D_MODEL), 0.02),
        'w_in': nrm(ks[3], (L, D_MODEL, IN_COLS), D_MODEL ** -0.5),
        'w_dw': nrm(ks[4], (L, CONV_WIDTH, CONV_CH), CONV_WIDTH ** -0.5),
        'b_dw': nrm(ks[5], (L, CONV_CH), 0.02),
        'conv_ln_g': 1.0 + nrm(ks[6], (L, CONV_CH), 0.02),
        'conv_ln_b': nrm(ks[7], (L, CONV_CH), 0.02),
        'beta_conv': 1.0 + nrm(ks[8], (L, CONV_CH), 0.02),
        'beta_attn': 1.0 + nrm(ks[9], (L, ATTN_WIDTH), 0.02),
        'w_out': nrm(ks[10], (L, D_MIX, D_MODEL), D_MIX ** -0.5),
        'g_ffn': 1.0 + nrm(ks[11], (L, D_MODEL), 0.02),
        'w_group': nrm(ks[12], (L, D_MODEL, N_GROUPS), D_MODEL ** -0.5),
        'b_group': nrm(ks[13], (L, N_GROUPS), 0.01),
        'w_erouter': nrm(ks[14], (L, N_GROUPS, D_MODEL, EXPERTS_PER_GROUP), D_MODEL ** -0.5),
        'b_erouter': nrm(ks[15], (L, N_GROUPS, EXPERTS_PER_GROUP), 0.01),
        'w_gate': nrm(ks[16], (L, N_EXPERTS, D_MODEL, D_EXPERT), D_MODEL ** -0.5),
        'w_up': nrm(ks[17], (L, N_EXPERTS, D_MODEL, D_EXPERT), D_MODEL ** -0.5),
        'w_down': nrm(ks[18], (L, N_EXPERTS, D_EXPERT, D_MODEL), D_EXPERT ** -0.5),
        'g_ple': 1.0 + nrm(ks[19], (L, D_MODEL), 0.02),
        'w_ple_gate': nrm(ks[20], (L, D_MODEL, D_MODEL), D_MODEL ** -0.5),
        'b_ple_gate': nrm(ks[21], (L, D_MODEL), 0.02),
        'w_ple_proj': nrm(ks[22], (L, PLE_DIM, D_MODEL), PLE_DIM ** -0.5),
        'g_final': 1.0 + nrm(ks[23], (D_MODEL,), 0.02),
    }


def reference(x, p, g_mix, w_in, w_dw, b_dw, conv_ln_g, conv_ln_b, beta_conv, beta_attn, w_out,
              g_ffn, w_group, b_group, w_erouter, b_erouter, w_gate, w_up, w_down,
              g_ple, w_ple_gate, b_ple_gate, w_ple_proj, g_final):
    B, S, _ = x.shape
    cos, sin = rope_tables(S)
    splits = [CONV_CH, 2 * CONV_CH, 2 * CONV_CH + ATTN_WIDTH, 2 * CONV_CH + 2 * ATTN_WIDTH]
    to_heads = lambda t: t.reshape(B, S, N_HEADS, HEAD_DIM).transpose(0, 2, 1, 3)
    for i in range(DEPTH):
        h = rms_norm(x, g_mix[i])
        proj = h @ w_in[i]
        c_val, c_gate, q, k, v = jnp.split(proj, splits, axis=-1)
        conv_out = conformer_conv(c_val, c_gate, w_dw[i], b_dw[i], conv_ln_g[i], conv_ln_b[i])
        q = partial_rope(to_heads(q), cos, sin)
        k = partial_rope(to_heads(k), cos, sin)
        attn = moba_attention(q, k, to_heads(v))
        attn = attn.transpose(0, 2, 1, 3).reshape(B, S, ATTN_WIDTH)
        mixed = jnp.concatenate([rms_norm(conv_out, beta_conv[i]), rms_norm(attn, beta_attn[i])], axis=-1)
        x = x + mixed @ w_out[i]
        x = x + hier_moe(rms_norm(x, g_ffn[i]), w_group[i], b_group[i], w_erouter[i], b_erouter[i],
                         w_gate[i], w_up[i], w_down[i])
        gate = jax.nn.sigmoid(rms_norm(x, g_ple[i]) @ w_ple_gate[i] + b_ple_gate[i])
        x = x + (p[i] @ w_ple_proj[i]) * gate
    return rms_norm(x, g_final)
```

```cpp
#include <hip/hip_runtime.h>
#include <cstdio>
#include <cstdint>
#include <cmath>

#define GAS __attribute__((address_space(1)))
#define LAS __attribute__((address_space(3)))
typedef _Float16 f16;
typedef _Float16 f16x2 __attribute__((ext_vector_type(2)));
typedef _Float16 f16x4 __attribute__((ext_vector_type(4)));
typedef _Float16 f16x8 __attribute__((ext_vector_type(8)));
typedef short s16x4 __attribute__((ext_vector_type(4)));
typedef short s16x8 __attribute__((ext_vector_type(8)));
typedef float f32x2 __attribute__((ext_vector_type(2)));
typedef float f32x4 __attribute__((ext_vector_type(4)));
typedef float f32x16 __attribute__((ext_vector_type(16)));
typedef unsigned u32x2 __attribute__((ext_vector_type(2)));
typedef unsigned u32x4 __attribute__((ext_vector_type(4)));

__device__ __forceinline__ unsigned pkh(float lo, float hi) { f16x2 h; h.x = (f16)lo; h.y = (f16)hi; return __builtin_bit_cast(unsigned, h); }
__device__ __forceinline__ float sigmoidf_(float v) { return __builtin_amdgcn_rcpf(1.0f + __builtin_amdgcn_exp2f(-1.4426950408889634f * v)); }

constexpr int NB = 16, S = 2048, D = 1024, M = NB * S;
constexpr int CC = 512, AW = 512, NH = 8, HD = 64, NIN = 2560, NE = 32, DE = 256, PLE = 256;
constexpr float EPS = 1e-6f;
constexpr int MAXT = 288;
constexpr int SROWS = MAXT * 256;

namespace pg8 {
#define PG8_LAS __attribute__((address_space(3)))
constexpr int BM = 256, BK = 64, HALF = 128, HTB = HALF * BK * 2, STAGE_BYTES = 8 * HTB, NXCD = 8, WGM = 8;
__host__ __device__ __forceinline__ int lds_byte(int r, int c) { const int st = (r >> 4) * 2 + (c >> 5), rr = r & 15, cc = c & 31, ob = rr * 64 + cc * 2; return st * 1024 + (ob ^ (((ob >> 9) & 1) << 5)); }
__host__ __device__ __forceinline__ void stage_rc(int b, int& R, int& C) { const int st = b / 1024, sb = b % 1024, swz = sb ^ (((sb >> 9) & 1) << 5); R = (st >> 1) * 16 + swz / 64; C = (st & 1) * 32 + (swz % 64) / 2; }
__host__ __device__ __forceinline__ int perm32(int rho) { const int n = rho >> 4, i = rho & 15; return 8 * (i >> 2) + 4 * n + (i & 3); }

struct Unit { int pm, pn; };
struct Gemm { const f16* A; const f16* Bt; int K; };

struct StaticOrder {
    int nM, nN, nwg, G, c;
    __device__ void init(int M_, int N_, int G_, int c_) { nM = M_ / BM; nN = N_ / BM; nwg = nM * nN; G = G_; c = c_; }
    __device__ bool next(int i, Unit& u) const {
        const long L = (long)i * G + c; if (L >= nwg) return false;
        int wgid = (int)L; { const int q = nwg / NXCD, r = nwg % NXCD, xcd = wgid % NXCD, off = wgid / NXCD; wgid = (xcd < r ? xcd * (q + 1) : r * (q + 1) + (xcd - r) * q) + off; }
        const int nig = WGM * nN, gid = wgid / nig, fm = gid * WGM, gsz = (nM - fm) < WGM ? (nM - fm) : WGM;
        u.pm = fm + ((wgid % nig) % gsz); u.pn = (wgid % nig) / gsz; return true;
    }
};
struct MoeOrder {
    int ntiles, nper, G, vcu; const LAS int* texp;
    __device__ bool next(int i, Unit& u) const {
        const int L = i * G + vcu; if (L >= ntiles * nper) return false;
        u.pm = L / nper; u.pn = __builtin_amdgcn_readfirstlane(texp[u.pm]) * nper + (L % nper); return true;
    }
};

template <class Epi, class Sched, bool ALIGN_EPI>
__device__ __forceinline__ void gemm_phase(PG8_LAS unsigned char* lds, PG8_LAS unsigned char* misc, const Gemm g, const Sched& S, const Epi& E) {
    int tid = threadIdx.x; asm volatile("" : "+v"(tid) :: "memory");
    const int wid = __builtin_amdgcn_readfirstlane(tid >> 6), lane = tid & 63, wr = wid >> 2, wc = wid & 3, fr = lane & 15, fq = lane >> 4;
    const int K = g.K, nt = K / BK;
    unsigned voffA[2], voffB[2];
#pragma unroll
    for (int i = 0; i < 2; ++i) { int R, C; stage_rc(tid * 16 + i * 8192, R, C); const int Rb = Epi::PERM ? ((R & ~31) + perm32(R & 31)) : R;
        voffA[i] = (unsigned)(R * K + C) * 2u; voffB[i] = (unsigned)(Rb * K + C) * 2u; }
    const size_t kstep = (size_t)(BK * 2);
    const size_t hstep = (size_t)HALF * K * 2;
    const size_t tstep = 2 * hstep;
    const unsigned ldsw = (unsigned)wid * 1024u;
    const int aoff = lds_byte(wr * 64 + fr, fq * 8), boff = lds_byte(wc * 32 + fr, fq * 8);
#define PG8_SA(b, h) (((b) * 2 + (h)) * HTB)
#define PG8_SB(b, h) ((4 + (b) * 2 + (h)) * HTB)
#define PG8_STAGE(bufoff, gbase, voff) do { _Pragma("unroll") for (int _i = 0; _i < 2; ++_i) \
        __builtin_amdgcn_global_load_lds((const unsigned*)((const char*)(gbase) + (voff)[_i]), (PG8_LAS unsigned*)(lds + (bufoff) + ldsw + _i * 8192), 16, 0, 0); } while (0)
#define PG8_LDA(dst, b, h) do { _Pragma("unroll") for (int m = 0; m < 4; ++m) _Pragma("unroll") for (int k = 0; k < 2; ++k) dst[m][k] = *(const PG8_LAS f16x8*)(lds + PG8_SA(b, h) + aoff + m * 2048 + k * 1024); } while (0)
#define PG8_LDB(dst, b, h) do { _Pragma("unroll") for (int n = 0; n < 2; ++n) _Pragma("unroll") for (int k = 0; k < 2; ++k) dst[n][k] = *(const PG8_LAS f16x8*)(lds + PG8_SB(b, h) + boff + n * 2048 + k * 1024); } while (0)
#define PG8_MMA(ai, bj, At, Bt) do { __builtin_amdgcn_s_setprio(1); _Pragma("unroll") for (int m = 0; m < 4; ++m) _Pragma("unroll") for (int n = 0; n < 2; ++n) _Pragma("unroll") for (int k = 0; k < 2; ++k) \
        acc[ai][bj][m][n] = __builtin_amdgcn_mfma_f32_16x16x32_f16(Bt[n][k], At[m][k], acc[ai][bj][m][n], 0, 0, 0); __builtin_amdgcn_s_setprio(0); } while (0)
#define PG8_WAIT_V(n) asm volatile("s_waitcnt vmcnt(" #n ")" ::: "memory")
#define PG8_WAIT_L(n) asm volatile("s_waitcnt lgkmcnt(" #n ")" ::: "memory")
#define PG8_BAR __builtin_amdgcn_s_barrier()
#define PG8_SCHED __builtin_amdgcn_sched_barrier(0)
    Unit cur, nxt; int ui = 0;
    if (!S.next(0, cur)) return;
    f32x4 acc[2][2][4][2];
#pragma unroll
    for (int a = 0; a < 2; ++a)
#pragma unroll
        for (int b = 0; b < 2; ++b)
#pragma unroll
            for (int m = 0; m < 4; ++m)
#pragma unroll
                for (int n = 0; n < 2; ++n) acc[a][b][m][n] = (f32x4){0.f, 0.f, 0.f, 0.f};
    f16x8 At[4][2], B0[2][2], B1[2][2];
    const char* cA = (const char*)g.A + (size_t)cur.pm * tstep; const char* cB = (const char*)g.Bt + (size_t)cur.pn * tstep;
    if constexpr (Epi::MIDSCALE) E.unit_begin(cur, ui, misc, tid);
    PG8_STAGE(PG8_SB(0, 0), cB, voffB); PG8_STAGE(PG8_SB(0, 1), cB + hstep, voffB); PG8_STAGE(PG8_SA(0, 0), cA, voffA); PG8_STAGE(PG8_SA(0, 1), cA + hstep, voffA);
    if (wr == 1) PG8_BAR;
    PG8_WAIT_V(2); PG8_BAR;
    PG8_STAGE(PG8_SB(1, 0), cB + kstep, voffB); PG8_STAGE(PG8_SA(1, 0), cA + kstep, voffA); PG8_STAGE(PG8_SB(1, 1), cB + hstep + kstep, voffB);
    PG8_WAIT_V(6); PG8_BAR;
    for (;;) {
        const bool has_next = S.next(ui + 1, nxt);
        const char* nA = has_next ? (const char*)g.A + (size_t)nxt.pm * tstep : cA; const char* nB = has_next ? (const char*)g.Bt + (size_t)nxt.pn * tstep : cB;
#pragma nounroll
        for (int t = 0; t < nt; t += 2) {
            const bool last = (t == nt - 2);
            const char* a1 = cA + (size_t)(t + 1) * kstep;
            const char* a2 = last ? nA : cA + (size_t)(t + 2) * kstep; const char* b2 = last ? nB : cB + (size_t)(t + 2) * kstep;
            const char* a3 = a2 + kstep; const char* b3 = b2 + kstep;
            if constexpr (Epi::MIDSCALE) { if (t == (nt >> 1)) E.midscale(acc, ui, wr, fr, misc); }
            PG8_LDB(B0, 0, 0); PG8_LDB(B1, 0, 1); PG8_SCHED; PG8_LDA(At, 0, 0); PG8_STAGE(PG8_SA(1, 1), a1 + hstep, voffA);
            PG8_WAIT_V(8); PG8_WAIT_L(0); PG8_BAR; PG8_MMA(0, 0, At, B0); PG8_MMA(0, 1, At, B1); PG8_BAR; PG8_SCHED;
            PG8_LDA(At, 0, 1); PG8_STAGE(PG8_SB(0, 0), b2, voffB); PG8_STAGE(PG8_SB(0, 1), b2 + hstep, voffB); PG8_STAGE(PG8_SA(0, 0), a2, voffA);
            PG8_WAIT_V(8); PG8_WAIT_L(0); PG8_BAR; PG8_MMA(1, 0, At, B0); PG8_MMA(1, 1, At, B1); PG8_BAR; PG8_SCHED;
            PG8_LDB(B0, 1, 0); PG8_LDB(B1, 1, 1); PG8_SCHED; PG8_LDA(At, 1, 0); PG8_STAGE(PG8_SA(0, 1), a2 + hstep, voffA);
            PG8_WAIT_V(8); PG8_WAIT_L(0); PG8_BAR; PG8_MMA(0, 0, At, B0); PG8_MMA(0, 1, At, B1); PG8_BAR; PG8_SCHED;
            PG8_LDA(At, 1, 1); PG8_STAGE(PG8_SB(1, 0), b3, voffB); PG8_STAGE(PG8_SB(1, 1), b3 + hstep, voffB); PG8_STAGE(PG8_SA(1, 0), a3, voffA);
            PG8_WAIT_V(8); PG8_WAIT_L(0); PG8_BAR; PG8_MMA(1, 0, At, B0); PG8_MMA(1, 1, At, B1); PG8_BAR; PG8_SCHED;
        }
        if constexpr (ALIGN_EPI) { if (wr == 0) PG8_BAR; }
        { int l2 = threadIdx.x; asm volatile("" : "+v"(l2)); l2 &= 63; E(acc, cur, wr, wc, l2 & 15, l2 >> 4); }
        if (!has_next) break;
#pragma unroll
        for (int a = 0; a < 2; ++a)
#pragma unroll
            for (int b = 0; b < 2; ++b)
#pragma unroll
                for (int m = 0; m < 4; ++m)
#pragma unroll
                    for (int n = 0; n < 2; ++n) acc[a][b][m][n] = (f32x4){0.f, 0.f, 0.f, 0.f};
        cur = nxt; cA = nA; cB = nB; ++ui;
        if constexpr (Epi::MIDSCALE) E.unit_begin(cur, ui, misc, tid);
        if constexpr (ALIGN_EPI) { if (wr == 1) PG8_BAR; }
    }
    PG8_WAIT_V(0);
    if constexpr (!ALIGN_EPI) { if (wr == 0) PG8_BAR; }
    PG8_BAR;
#undef PG8_SA
#undef PG8_SB
#undef PG8_STAGE
#undef PG8_LDA
#undef PG8_LDB
#undef PG8_MMA
#undef PG8_WAIT_V
#undef PG8_WAIT_L
#undef PG8_BAR
#undef PG8_SCHED
}

constexpr float C2 = 0.125f * 1.4426950408889634f;
struct Epi1 {
    static constexpr bool PERM = true, MIDSCALE = false;
    f16 *U, *Q, *Kb, *V; const float* rope; float* kpart;
    template <bool ROT> __device__ __forceinline__ void qk_tile(const f32x4 (&acc)[2][2][4][2], const Unit& u, int row0, int cl, int fr, int fq, int wr) const {
        const bool isq = u.pn < 6; char* dst = (char*)(isq ? Q : Kb); const int cb = (u.pn & 1) * 256; const float sc = isq ? C2 : 1.0f;
        const float sgn = (fq == 0) ? -1.0f : ((fq == 1) ? 1.0f : 0.0f); const bool lowq = fq < 2;
#pragma unroll
        for (int bj = 0; bj < 2; ++bj) {
            f32x4 cs0 = (f32x4){0.f, 0.f, 0.f, 0.f}, cs1 = cs0;
#pragma unroll
            for (int ai = 0; ai < 2; ++ai)
#pragma unroll
                for (int m = 0; m < 4; ++m) { const int row = row0 + ai * HALF + m * 16;
                    f32x4 v0 = acc[ai][bj][m][0], v1 = acc[ai][bj][m][1];
                    if (ROT) { const float* rp = rope + (unsigned)(row & (S - 1)) * 16u;
                        f32x4 c0 = *(const f32x4*)(rp), c1 = *(const f32x4*)(rp + 4); const f32x4 s0 = *(const f32x4*)(rp + 8) * sgn, s1 = *(const f32x4*)(rp + 12) * sgn;
#pragma unroll
                        for (int e = 0; e < 4; ++e) { c0[e] = lowq ? c0[e] : 1.0f; c1[e] = lowq ? c1[e] : 1.0f; }
                        f32x4 p0, p1;
#pragma unroll
                        for (int e = 0; e < 4; ++e) { p0[e] = __shfl_xor(v0[e], 16); p1[e] = __shfl_xor(v1[e], 16); }
                        v0 = v0 * c0 + p0 * s0; v1 = v1 * c1 + p1 * s1; }
                    v0 = v0 * sc; v1 = v1 * sc;
                    u32x4 w; w.x = pkh(v0[0], v0[1]); w.y = pkh(v0[2], v0[3]); w.z = pkh(v1[0], v1[1]); w.w = pkh(v1[2], v1[3]);
                    *(u32x4*)(dst + ((unsigned)row * (unsigned)AW + (unsigned)(cb + bj * HALF + cl)) * 2u) = w;
                    cs0 += v0; cs1 += v1; asm volatile("" : "+v"(cs0), "+v"(cs1) :: "memory"); }
            if (!isq) {
#pragma unroll
                for (int e = 0; e < 4; ++e) { float v = cs0[e]; v += __shfl_xor(v, 1); v += __shfl_xor(v, 2); v += __shfl_xor(v, 4); v += __shfl_xor(v, 8); cs0[e] = v;
                    float y = cs1[e]; y += __shfl_xor(y, 1); y += __shfl_xor(y, 2); y += __shfl_xor(y, 4); y += __shfl_xor(y, 8); cs1[e] = y; }
                if (fr == 0) { float* kp = kpart + (unsigned)(wr * 128 + u.pm) * (unsigned)AW + (unsigned)(cb + bj * HALF + cl); *(f32x4*)kp = cs0; *(f32x4*)(kp + 4) = cs1; }
            }
        }
    }
    __device__ __forceinline__ void operator()(const f32x4 (&acc)[2][2][4][2], const Unit& u, int wr, int wc, int fr, int fq) const {
        const int row0 = u.pm * BM + wr * 64 + fr, cl = wc * 32 + 8 * fq;
        if (u.pn < 4) {
#pragma unroll
            for (int ai = 0; ai < 2; ++ai)
#pragma unroll
                for (int m = 0; m < 4; ++m) { const size_t row = (size_t)(row0 + ai * HALF + m * 16);
                    const f32x4 v0 = acc[ai][0][m][0], v1 = acc[ai][0][m][1], g0 = acc[ai][1][m][0], g1 = acc[ai][1][m][1];
                    u32x4 w; w.x = pkh(v0[0] * sigmoidf_(g0[0]), v0[1] * sigmoidf_(g0[1])); w.y = pkh(v0[2] * sigmoidf_(g0[2]), v0[3] * sigmoidf_(g0[3]));
                    w.z = pkh(v1[0] * sigmoidf_(g1[0]), v1[1] * sigmoidf_(g1[1])); w.w = pkh(v1[2] * sigmoidf_(g1[2]), v1[3] * sigmoidf_(g1[3]));
                    *(u32x4*)(U + row * CC + u.pn * 128 + cl) = w; asm volatile("" ::: "memory"); }
        } else if (u.pn < 8) {
            if ((wc & 1) == 0) qk_tile<true>(acc, u, row0, cl, fr, fq, wr); else qk_tile<false>(acc, u, row0, cl, fr, fq, wr);
        } else {
            const int cb = (u.pn & 1) * 256;
#pragma unroll
            for (int ai = 0; ai < 2; ++ai)
#pragma unroll
                for (int m = 0; m < 4; ++m) { const size_t row = (size_t)(row0 + ai * HALF + m * 16);
#pragma unroll
                    for (int bj = 0; bj < 2; ++bj) { const f32x4 v0 = acc[ai][bj][m][0], v1 = acc[ai][bj][m][1];
                        u32x4 w; w.x = pkh(v0[0], v0[1]); w.y = pkh(v0[2], v0[3]); w.z = pkh(v1[0], v1[1]); w.w = pkh(v1[2], v1[3]);
                        *(u32x4*)(V + row * AW + cb + bj * HALF + cl) = w; } }
        }
    }
};
struct EpiH {
    static constexpr bool PERM = true, MIDSCALE = false;
    f16* O; int ldc;
    __device__ __forceinline__ void operator()(const f32x4 (&acc)[2][2][4][2], const Unit& u, int wr, int wc, int fr, int fq) const {
        const int row0 = u.pm * BM + wr * 64 + fr, col0 = u.pn * BM + wc * 32 + 8 * fq;
#pragma unroll
        for (int ai = 0; ai < 2; ++ai)
#pragma unroll
            for (int m = 0; m < 4; ++m) { f16* rp = O + (size_t)(row0 + ai * HALF + m * 16) * ldc + col0;
#pragma unroll
                for (int bj = 0; bj < 2; ++bj) { const f32x4 v0 = acc[ai][bj][m][0], v1 = acc[ai][bj][m][1];
                    u32x4 w; w.x = pkh(v0[0], v0[1]); w.y = pkh(v0[2], v0[3]); w.z = pkh(v1[0], v1[1]); w.w = pkh(v1[2], v1[3]);
                    *(u32x4*)(rp + bj * HALF) = w; } }
    }
};
struct Epi2 {
    static constexpr bool PERM = true, MIDSCALE = true;
    const float* x; float* x1; f16* x1h; const float* ssqa;
    __device__ __forceinline__ void unit_begin(const Unit& u, int ui, PG8_LAS unsigned char* misc, int tid) const {
        if (tid < 256) { const float* p = ssqa + (size_t)(u.pm * BM + tid) * 8; const f32x4 a = *(const f32x4*)p, b = *(const f32x4*)(p + 4);
            const float s = ((a[0] + a[1]) + (a[2] + a[3])) + ((b[0] + b[1]) + (b[2] + b[3]));
            ((PG8_LAS float*)(misc + 512))[(ui & 1) * 256 + tid] = __builtin_amdgcn_rsqf(s * (1.0f / AW) + EPS); }
    }
    __device__ __forceinline__ void midscale(f32x4 (&acc)[2][2][4][2], int ui, int wr, int fr, PG8_LAS unsigned char* misc) const {
        const PG8_LAS float* rb = (const PG8_LAS float*)(misc + 512) + (ui & 1) * 256 + wr * 64 + fr;
#pragma unroll
        for (int ai = 0; ai < 2; ++ai)
#pragma unroll
            for (int m = 0; m < 4; ++m) { const float s = rb[ai * HALF + m * 16];
#pragma unroll
                for (int bj = 0; bj < 2; ++bj)
#pragma unroll
                    for (int n = 0; n < 2; ++n) acc[ai][bj][m][n] = acc[ai][bj][m][n] * s; }
    }
    __device__ __forceinline__ void operator()(const f32x4 (&acc)[2][2][4][2], const Unit& u, int wr, int wc, int fr, int fq) const {
        const int row0 = u.pm * BM + wr * 64 + fr, col0 = u.pn * BM + wc * 32 + 8 * fq;
#pragma unroll
        for (int ai = 0; ai < 2; ++ai)
#pragma unroll
            for (int m = 0; m < 4; ++m) { const size_t off = (size_t)(row0 + ai * HALF + m * 16) * D + col0;
#pragma unroll
                for (int bj = 0; bj < 2; ++bj) { const f32x4 v0 = acc[ai][bj][m][0] + *(const f32x4*)(x + off + bj * HALF), v1 = acc[ai][bj][m][1] + *(const f32x4*)(x + off + bj * HALF + 4);
                    *(f32x4*)(x1 + off + bj * HALF) = v0; *(f32x4*)(x1 + off + bj * HALF + 4) = v1;
                    u32x4 w; w.x = pkh(v0[0], v0[1]); w.y = pkh(v0[2], v0[3]); w.z = pkh(v1[0], v1[1]); w.w = pkh(v1[2], v1[3]);
                    *(u32x4*)(x1h + off + bj * HALF) = w; } asm volatile("" ::: "memory"); }
    }
};
struct EpiGU {
    static constexpr bool PERM = true, MIDSCALE = false;
    f16* Hs; const float* mRs; const float* mW;
    __device__ __forceinline__ void operator()(const f32x4 (&acc)[2][2][4][2], const Unit& u, int wr, int wc, int fr, int fq) const {
        const int row0 = u.pm * BM + wr * 64 + fr, col0 = (u.pn & 1) * 128 + wc * 32 + 8 * fq;
#pragma unroll
        for (int ai = 0; ai < 2; ++ai)
#pragma unroll
            for (int m = 0; m < 4; ++m) { const int row = row0 + ai * HALF + m * 16; const float rs = mRs[row], wt = mW[row] * rs;
                float h[8];
#pragma unroll
                for (int n = 0; n < 2; ++n)
#pragma unroll
                    for (int e = 0; e < 4; ++e) { const float gg = acc[ai][0][m][n][e] * rs, uu = acc[ai][1][m][n][e] * wt; h[n * 4 + e] = gg * sigmoidf_(gg) * uu; }
                u32x4 w; w.x = pkh(h[0], h[1]); w.y = pkh(h[2], h[3]); w.z = pkh(h[4], h[5]); w.w = pkh(h[6], h[7]);
                *(u32x4*)(Hs + (size_t)row * DE + col0) = w; asm volatile("" ::: "memory"); }
    }
};
struct EpiDN {
    static constexpr bool PERM = true, MIDSCALE = false;
    f16* Y; const int* mTok;
    __device__ __forceinline__ void operator()(const f32x4 (&acc)[2][2][4][2], const Unit& u, int wr, int wc, int fr, int fq) const {
        const int row0 = u.pm * BM + wr * 64 + fr, col0 = (u.pn & 3) * BM + wc * 32 + 8 * fq;
#pragma unroll
        for (int ai = 0; ai < 2; ++ai)
#pragma unroll
            for (int m = 0; m < 4; ++m) { const int t2 = mTok[row0 + ai * HALF + m * 16];
                if (t2 >= 0) { const unsigned off = (((unsigned)(t2 & 1) * (unsigned)M + (unsigned)(t2 >> 1)) * (unsigned)D + (unsigned)col0) * 2u;
#pragma unroll
                    for (int bj = 0; bj < 2; ++bj) { const f32x4 v0 = acc[ai][bj][m][0], v1 = acc[ai][bj][m][1];
                        u32x4 w; w.x = pkh(v0[0], v0[1]); w.y = pkh(v0[2], v0[3]); w.z = pkh(v1[0], v1[1]); w.w = pkh(v1[2], v1[3]);
                        *(u32x4*)((char*)Y + off + bj * HALF * 2) = w; } } }
    }
};
struct EpiPLE {
    static constexpr bool PERM = true, MIDSCALE = false;
    float* xio; const f16* PP; const float* bias; float* ssqf;
    __device__ __forceinline__ void operator()(const f32x4 (&acc)[2][2][4][2], const Unit& u, int wr, int wc, int fr, int fq) const {
        const int row0 = u.pm * BM + wr * 64 + fr, col0 = u.pn * BM + wc * 32 + 8 * fq;
        f32x4 bv[2][2];
#pragma unroll
        for (int bj = 0; bj < 2; ++bj) { bv[bj][0] = *(const f32x4*)(bias + col0 + bj * HALF); bv[bj][1] = *(const f32x4*)(bias + col0 + bj * HALF + 4); }
#pragma unroll
        for (int ai = 0; ai < 2; ++ai)
#pragma unroll
            for (int m = 0; m < 4; ++m) { const int row = row0 + ai * HALF + m * 16; const size_t off = (size_t)row * D + col0; float ss = 0.f;
#pragma unroll
                for (int bj = 0; bj < 2; ++bj) { const f16x8 pp = *(const f16x8*)(PP + off + bj * HALF);
                    f32x4 x0 = *(const f32x4*)(xio + off + bj * HALF), x1 = *(const f32x4*)(xio + off + bj * HALF + 4);
#pragma unroll
                    for (int e = 0; e < 4; ++e) { x0[e] += (float)pp[e] * sigmoidf_(acc[ai][bj][m][0][e] + bv[bj][0][e]); x1[e] += (float)pp[4 + e] * sigmoidf_(acc[ai][bj][m][1][e] + bv[bj][1][e]); }
                    *(f32x4*)(xio + off + bj * HALF) = x0; *(f32x4*)(xio + off + bj * HALF + 4) = x1;
                    ss += (x0[0] * x0[0] + x0[1] * x0[1]) + (x0[2] * x0[2] + x0[3] * x0[3]) + (x1[0] * x1[0] + x1[1] * x1[1]) + (x1[2] * x1[2] + x1[3] * x1[3]); }
                ss += __shfl_xor(ss, 16); ss += __shfl_xor(ss, 32);
                if (fq == 0) ssqf[(size_t)row * 16 + u.pn * 4 + wc] = ss; asm volatile("" ::: "memory"); }
    }
};
}

namespace att {
constexpr int NSLOT = 3, SLOTB = 8192;
constexpr int L_K = 0, L_V = NSLOT * SLOTB, L_WS = 2 * NSLOT * SLOTB, L_OST = L_WS + 8 * 64 * 4, L_KM = L_OST + 8 * 4096, L_END = L_KM + 8 * 64 * 4;
__device__ __forceinline__ int crow(int r, int hi) { return (r & 3) + 8 * (r >> 2) + 4 * hi; }
#define ATT_SBAR() __builtin_amdgcn_sched_barrier(0)
#define ATT_WAIT_BAR(N) asm volatile("s_waitcnt vmcnt(" #N ") lgkmcnt(0)\n\ts_barrier" ::: "memory")
__device__ __forceinline__ void glds16(const void* gsrc, unsigned lds_dst) { unsigned keep;
    asm volatile("s_mov_b32 %0, m0\n\ts_mov_b32 m0, %2\n\ts_nop 0\n\tglobal_load_lds_dwordx4 %1, off\n\ts_mov_b32 m0, %0" : "=&s"(keep) : "v"(gsrc), "s"(lds_dst) : "memory"); }
__device__ __forceinline__ void qkt(f32x16& p0, f32x16& p1, const char* Kslot, const f16x8* qr, const f32x16& negm, int r32, int hi) {
    const char* kb = Kslot + hi * 1024 + r32 * 16;
#pragma unroll
    for (int d0 = 0; d0 < 4; ++d0) {
        const f16x8 b0 = *reinterpret_cast<const f16x8*>(kb + d0 * 2048);
        const f16x8 b1 = *reinterpret_cast<const f16x8*>(kb + d0 * 2048 + 512);
        if (d0 == 0) { p0 = __builtin_amdgcn_mfma_f32_32x32x16_f16(b0, qr[0], negm, 0, 0, 0); p1 = __builtin_amdgcn_mfma_f32_32x32x16_f16(b1, qr[0], negm, 0, 0, 0); }
        else { p0 = __builtin_amdgcn_mfma_f32_32x32x16_f16(b0, qr[d0], p0, 0, 0, 0); p1 = __builtin_amdgcn_mfma_f32_32x32x16_f16(b1, qr[d0], p1, 0, 0, 0); } }
}
__device__ __forceinline__ float rowmax(const f32x16& p0, const f32x16& p1) {
    float a = fmaxf(p0[0], p1[0]);
#pragma unroll
    for (int r = 1; r < 16; ++r) a = fmaxf(a, fmaxf(p0[r], p1[r]));
    auto rr = __builtin_amdgcn_permlane32_swap(__float_as_uint(a), __float_as_uint(a), false, false);
    return fmaxf(__uint_as_float(rr[0]), __uint_as_float(rr[1]));
}
__device__ __forceinline__ void pv(f32x16* o, int vb, f16x8 pa0, f16x8 pa1, f16x8 pa2, f16x8 pa3) {
#pragma unroll
    for (int d0 = 0; d0 < 2; ++d0) { s16x4 lo[4], hi[4];
#pragma unroll
        for (int ks = 0; ks < 4; ++ks) {
            asm volatile("ds_read_b64_tr_b16 %0,%1 offset:%c2" : "=&v"(lo[ks]) : "v"(vb), "i"(d0 * 4096 + ks * 1024) : "memory");
            asm volatile("ds_read_b64_tr_b16 %0,%1 offset:%c2" : "=&v"(hi[ks]) : "v"(vb), "i"(d0 * 4096 + ks * 1024 + 512) : "memory"); }
        asm volatile("s_waitcnt lgkmcnt(0)" ::: "memory"); ATT_SBAR();
#define ATT_PK(k) __builtin_bit_cast(f16x8, (s16x8){lo[k][0], lo[k][1], lo[k][2], lo[k][3], hi[k][0], hi[k][1], hi[k][2], hi[k][3]})
        o[d0] = __builtin_amdgcn_mfma_f32_32x32x16_f16(pa0, ATT_PK(0), o[d0], 0, 0, 0);
        o[d0] = __builtin_amdgcn_mfma_f32_32x32x16_f16(pa1, ATT_PK(1), o[d0], 0, 0, 0);
        o[d0] = __builtin_amdgcn_mfma_f32_32x32x16_f16(pa2, ATT_PK(2), o[d0], 0, 0, 0);
        o[d0] = __builtin_amdgcn_mfma_f32_32x32x16_f16(pa3, ATT_PK(3), o[d0], 0, 0, 0);
#undef ATT_PK
    }
}
template <int THRL> __device__ __forceinline__ void unit(int b, int h, int qb, const f16* Q, const f16* __restrict__ K, const f16* __restrict__ V, f16* O, float* ssqa, const float* kpart, char* shm, int tid) {
    const int lane = tid & 63, r32 = lane & 31, hi = lane >> 5; const int wid = __builtin_amdgcn_readfirstlane(tid >> 6);
    const long rowbase = (long)b * S; const int q0 = qb * 256;
    const f16* Qw = Q + (rowbase + q0 + wid * 32) * AW + h * HD;
    const f16* Kh = K + rowbase * AW + h * HD; const f16* Vh = V + rowbase * AW + h * HD;
    const unsigned lds0 = (unsigned)(uintptr_t)shm;
    float* wsf = (float*)(shm + L_WS) + wid * 64;
    float* km = (float*)(shm + L_KM);
    { const int n = tid >> 6, d = tid & 63; float v = 0.f;
      if (n < qb) { const size_t o = (size_t)(b * 8 + n) * AW + h * HD + d; v = (kpart[o] + kpart[(size_t)128 * AW + o]) * (1.0f / 256.0f); }
      km[tid] = v; }
    const f16* ksrc = Kh + (long)lane * AW + wid * 8;
    const f16* vsrc = Vh + (long)(16 * (wid & 3) + (lane >> 2)) * AW + (wid >> 2) * 32 + (lane & 3) * 8;
    const unsigned kdst = lds0 + L_K + wid * 1024, vdst = lds0 + L_V + wid * 1024;
#define ATT_KROW(t) ((t) < 4 ? (q0 + 64 * (t)) : 64 * ((t) - 4))
#define ATT_DMA_K(t, slot) glds16(ksrc + (long)ATT_KROW(t) * AW, (unsigned)__builtin_amdgcn_readfirstlane(kdst + (slot)))
#define ATT_DMA_V(t, slot) glds16(vsrc + (long)ATT_KROW(t) * AW, (unsigned)__builtin_amdgcn_readfirstlane(vdst + (slot)))
    const int vb0 = (int)(lds0 + L_V) + ((lane >> 4) & 1) * 32 + (lane & 3) * 8 + (4 * hi + ((lane & 15) >> 2)) * 64;
    const char* Kbase = shm + L_K;
    const int NT = 4 + 4 * qb;
    ATT_DMA_K(0, 0); ATT_DMA_V(0, 0);
    f16x8 qr[4];
#pragma unroll
    for (int d0 = 0; d0 < 4; ++d0) qr[d0] = *reinterpret_cast<const f16x8*>(&Qw[(long)r32 * AW + d0 * 16 + hi * 8]);
    asm volatile("s_waitcnt lgkmcnt(0)\n\ts_barrier" ::: "memory");
    unsigned sel = 0u;
    {
        float g[7];
#pragma unroll
        for (int n = 0; n < 7; ++n) g[n] = 0.f;
#pragma unroll
        for (int d0 = 0; d0 < 4; ++d0) {
            float qf[8];
#pragma unroll
            for (int j = 0; j < 8; ++j) qf[j] = (float)qr[d0][j];
#pragma unroll
            for (int n = 0; n < 7; ++n) { const f32x4 k0 = *(const f32x4*)(km + n * 64 + 16 * d0 + 8 * hi), k1 = *(const f32x4*)(km + n * 64 + 16 * d0 + 8 * hi + 4);
                g[n] += (qf[0] * k0[0] + qf[1] * k0[1]) + (qf[2] * k0[2] + qf[3] * k0[3]) + (qf[4] * k1[0] + qf[5] * k1[1]) + (qf[6] * k1[2] + qf[7] * k1[3]); }
            asm volatile("" ::: "memory");
        }
#pragma unroll
        for (int n = 0; n < 7; ++n) g[n] += __shfl_xor(g[n], 32);
        if (qb <= 3) sel = (1u << qb) - 1u;
        else {
#pragma unroll
            for (int n = 0; n < 7; ++n) { int rank = 0;
#pragma unroll
                for (int m2 = 0; m2 < 7; ++m2) if (m2 != n) rank += (m2 < qb && (g[m2] > g[n] || (g[m2] == g[n] && m2 < n))) ? 1 : 0;
                if (n < qb && rank < 3) sel |= 1u << n; }
        }
    }
    float mhat = 0.f, l_reg = 0.f; f32x16 o[2]; o[0] = f32x16{}; o[1] = f32x16{}; f32x16 negm = f32x16{};
    const int qrel = wid * 32 + r32;
    int slot = 0, nslot = SLOTB;
    for (int t = 0; t < NT; ++t) {
        if (t + 1 < NT) { ATT_DMA_K(t + 1, nslot); ATT_DMA_V(t + 1, nslot); ATT_WAIT_BAR(2); } else { ATT_WAIT_BAR(0); }
        const int pb = (t - 4) >> 2;
        const bool mine = (t < 4) ? true : (((sel >> pb) & 1u) != 0u);
        const bool active = (t < 4) ? (64 * t <= 32 * wid + 31) : (__any(mine ? 1 : 0) != 0);
        if (active) {
            f32x16 p0, p1;
            qkt(p0, p1, Kbase + slot, qr, negm, r32, hi);
            if (t < 4) { const int kb = 64 * t + 4 * hi;
#pragma unroll
                for (int r = 0; r < 16; ++r) { const int kv = kb + (r & 3) + 8 * (r >> 2); if (kv > qrel) p0[r] = -INFINITY; if (kv + 32 > qrel) p1[r] = -INFINITY; } }
            else if (!mine) {
#pragma unroll
                for (int r = 0; r < 16; ++r) { p0[r] = -INFINITY; p1[r] = -INFINITY; } }
            const float rm = rowmax(p0, p1);
            if (t == 0) { mhat = rm;
#pragma unroll
                for (int r = 0; r < 16; ++r) { p0[r] -= rm; p1[r] -= rm; negm[r] = -mhat; } }
            else if (__any(rm > (float)THRL)) { const float dl = fmaxf(rm, 0.f); mhat += dl;
#pragma unroll
                for (int r = 0; r < 16; ++r) { p0[r] -= dl; p1[r] -= dl; negm[r] = -mhat; }
                const float f = __builtin_amdgcn_exp2f(-dl); l_reg *= f; if (hi == 0) wsf[r32] = f;
                asm volatile("s_waitcnt lgkmcnt(0)" ::: "memory");
#pragma unroll
                for (int r = 0; r < 16; ++r) { const float fr_ = wsf[crow(r, hi)]; o[0][r] *= fr_; o[1][r] *= fr_; } }
            float sacc = 0.f;
#pragma unroll
            for (int r = 0; r < 16; ++r) { p0[r] = __builtin_amdgcn_exp2f(p0[r]); p1[r] = __builtin_amdgcn_exp2f(p1[r]); sacc += p0[r] + p1[r]; }
            l_reg += sacc;
            u32x4 pw0, pw1, pw2, pw3;
            pw0 = (u32x4){pkh(p0[0], p0[1]), pkh(p0[2], p0[3]), pkh(p0[4], p0[5]), pkh(p0[6], p0[7])};
            pw1 = (u32x4){pkh(p0[8], p0[9]), pkh(p0[10], p0[11]), pkh(p0[12], p0[13]), pkh(p0[14], p0[15])};
            pw2 = (u32x4){pkh(p1[0], p1[1]), pkh(p1[2], p1[3]), pkh(p1[4], p1[5]), pkh(p1[6], p1[7])};
            pw3 = (u32x4){pkh(p1[8], p1[9]), pkh(p1[10], p1[11]), pkh(p1[12], p1[13]), pkh(p1[14], p1[15])};
            pv(o, vb0 + slot, __builtin_bit_cast(f16x8, pw0), __builtin_bit_cast(f16x8, pw1), __builtin_bit_cast(f16x8, pw2), __builtin_bit_cast(f16x8, pw3));
        }
        slot = nslot; nslot = (nslot == (NSLOT - 1) * SLOTB) ? 0 : nslot + SLOTB;
    }
    { auto rr = __builtin_amdgcn_permlane32_swap(__float_as_uint(l_reg), __float_as_uint(l_reg), false, false); l_reg = __uint_as_float(rr[0]) + __uint_as_float(rr[1]); }
    if (hi == 0) wsf[32 + r32] = l_reg; asm volatile("s_waitcnt lgkmcnt(0)" ::: "memory");
    float rli[16];
#pragma unroll
    for (int r = 0; r < 16; ++r) rli[r] = __builtin_amdgcn_rcpf(wsf[32 + crow(r, hi)]);
    f16* Ow = O + (rowbase + q0 + wid * 32) * D + h * HD;
    { f16* stg = (f16*)(shm + L_OST) + wid * 2048;
#pragma unroll
      for (int r = 0; r < 16; ++r) { const int orow = crow(r, hi);
#pragma unroll
          for (int d0 = 0; d0 < 2; ++d0) stg[orow * 64 + d0 * 32 + r32] = (f16)(o[d0][r] * rli[r]); }
      asm volatile("s_waitcnt lgkmcnt(0)" ::: "memory");
#pragma unroll
      for (int i = 0; i < 4; ++i) { const int row = i * 8 + (lane >> 3), ch = lane & 7; const f16x8 v = *(const f16x8*)(stg + row * 64 + ch * 8);
          *(f16x8*)(Ow + (long)row * D + ch * 8) = v;
          float ss = 0.f;
#pragma unroll
          for (int e = 0; e < 8; ++e) { const float f = (float)v[e]; ss += f * f; }
          ss += __shfl_xor(ss, 1); ss += __shfl_xor(ss, 2); ss += __shfl_xor(ss, 4);
          if (ch == 0) ssqa[(size_t)(rowbase + q0 + wid * 32 + row) * 8 + h] = ss; } }
    asm volatile("s_waitcnt vmcnt(0) lgkmcnt(0)\n\ts_barrier" ::: "memory");
#undef ATT_KROW
#undef ATT_DMA_K
#undef ATT_DMA_V
}
}

constexpr size_t MiB = 1u << 20, KiB = 1u << 10;
constexpr size_t WS_CTL = 0, CTL_ZERO_BYTES = 1 * MiB;
constexpr size_t WS_ROPE = 1 * MiB;
constexpr size_t WS_KPART = 2 * MiB;
constexpr size_t WS_WRF = 3 * MiB;
constexpr size_t WS_SSQA = 4 * MiB;
constexpr size_t WS_SSQF = 5 * MiB;
constexpr size_t WS_RS2 = 7 * MiB;
constexpr size_t WS_RE = 7 * MiB + 128 * KiB;
constexpr size_t WS_RW = 7 * MiB + 384 * KiB;
constexpr size_t WS_RPOS = 7 * MiB + 640 * KiB;
constexpr size_t WS_MTOK = 8 * MiB;
constexpr size_t WS_MW = 8 * MiB + 320 * KiB;
constexpr size_t WS_MRS = 8 * MiB + 640 * KiB;
constexpr size_t WS_PH = 10 * MiB;
constexpr size_t WS_WIN = 26 * MiB, WS_WPP = 31 * MiB, WS_WOUT = 32 * MiB, WS_WPG = 34 * MiB, WS_WGU = 36 * MiB, WS_WD = 68 * MiB;
constexpr size_t WS_XN = 84 * MiB;
constexpr size_t WS_U = 148 * MiB, WS_Q = 180 * MiB, WS_K = 212 * MiB, WS_V = 244 * MiB;
constexpr size_t WS_MIX = 276 * MiB;
constexpr size_t WS_PP = 340 * MiB;
constexpr size_t WS_HS = 404 * MiB;
constexpr size_t WS_XS = 148 * MiB;
constexpr size_t WS_Y = 148 * MiB;
constexpr size_t WS_END = 440 * MiB;
static_assert(WS_XS + (size_t)SROWS * D * 2 <= WS_PP && WS_HS + (size_t)SROWS * DE * 2 <= WS_END && WS_MRS + SROWS * 4 <= 10 * MiB, "ws map");
constexpr int CW_CNT = 1024;
constexpr int CW_BAR = 4096;

constexpr int RING_OFF = 0, RING_BYTES = 131072;
constexpr int MISC_OFF = RING_BYTES;
constexpr int LDS_BYTES = 147456;
constexpr int NWAVES = 8;

typedef GAS unsigned gu32;
#define RLX_AGENT __ATOMIC_RELAXED, __HIP_MEMORY_SCOPE_AGENT
#define LDS_WAIT() asm volatile("s_waitcnt lgkmcnt(0)" ::: "memory")

#define XB_TMO      128
#define XB_XCNT(j)  (256  + 64 * (j))
#define XB_XSUB(j)  (1280 + 64 * (j))
#define XB_XGEN(j)  (2304 + 64 * (j))
#define XB_TOP      3328
#define XB_TOPGEN   3392
#define XB_SPIN_CAP (1u << 18)
__device__ __forceinline__ unsigned xb_ld(unsigned* p)              { return __hip_atomic_load(p, __ATOMIC_RELAXED, __HIP_MEMORY_SCOPE_AGENT); }
__device__ __forceinline__ unsigned xb_add(unsigned* p, unsigned v) { return __hip_atomic_fetch_add(p, v, __ATOMIC_RELAXED, __HIP_MEMORY_SCOPE_AGENT); }
__device__ __forceinline__ unsigned xb_xcc_id() { return (unsigned)__builtin_amdgcn_s_getreg((3 << 11) | 20) & 0xFu; }
#define XB_SPIN(cond, bar) do { unsigned _sp = 0; while (cond) { __builtin_amdgcn_s_sleep(1); \
    if ((++_sp & 255u) == 0u) { if (xb_ld(&(bar)[XB_TMO])) break; if (_sp > XB_SPIN_CAP) { atomicAdd(&(bar)[XB_TMO], 1u); break; } } } } while (0)
struct XcdBarrier { unsigned* bar; unsigned x; volatile LAS unsigned* st; };
__device__ __forceinline__ XcdBarrier xcd_barrier_post(unsigned* bar, volatile LAS unsigned* st) {
    XcdBarrier b; b.bar = bar; b.x = xb_xcc_id(); b.st = st;
    if (threadIdx.x == 0) (void)xb_add(&bar[XB_XCNT(b.x)], 1u);
    return b;
}
__device__ __forceinline__ void xcd_barrier_complete(unsigned* bar, unsigned x, unsigned& nloc, unsigned& nx) {
    const unsigned G = gridDim.x * gridDim.y * gridDim.z;
    unsigned sum, cnt, mine, sp = 0u;
    for (;;) {
        sum = 0u; cnt = 0u; mine = 0u;
#pragma unroll
        for (unsigned j = 0; j < 16; ++j) { const unsigned c = xb_ld(&bar[XB_XCNT(j)]); sum += c; cnt += (c > 0u) ? 1u : 0u; mine = (j == x) ? c : mine; }
        if (sum == G) break;
        __builtin_amdgcn_s_sleep(1);
        if ((++sp & 255u) == 0u) { if (xb_ld(&bar[XB_TMO])) break; if (sp > XB_SPIN_CAP) { atomicAdd(&bar[XB_TMO], 1u); break; } }
    }
    nloc = mine > 0u ? mine : 1u; nx = cnt > 0u ? cnt : 1u;
}
__device__ __forceinline__ void xcd_barrier(const XcdBarrier& b) {
    asm volatile("s_waitcnt vmcnt(0)" ::: "memory");
    __syncthreads();
    if (threadIdx.x == 0) {
        unsigned* bar = b.bar;
        __builtin_amdgcn_s_waitcnt(0);
        unsigned nloc = b.st[0], nx = b.st[1];
        if (nloc == 0u) { xcd_barrier_complete(bar, b.x, nloc, nx); b.st[0] = nloc; b.st[1] = nx; }
        const unsigned old = xb_add(&bar[XB_XSUB(b.x)], 1u);
        const unsigned gen = old / nloc;
        if (old + 1u == (gen + 1u) * nloc) {
            __builtin_amdgcn_fence(__ATOMIC_RELEASE, "agent");
            asm volatile("s_waitcnt vmcnt(0)" ::: "memory");
            const unsigned og = xb_add(&bar[XB_TOP], 1u);
            const unsigned tg = og / nx;
            if (og + 1u == (tg + 1u) * nx) xb_add(&bar[XB_TOPGEN], 1u);
            else XB_SPIN(xb_ld(&bar[XB_TOPGEN]) == tg, bar);
            __builtin_amdgcn_fence(__ATOMIC_ACQUIRE, "agent");
            xb_add(&bar[XB_XGEN(b.x)], 1u);
            asm volatile("s_waitcnt vmcnt(0)" ::: "memory");
        } else {
            XB_SPIN(xb_ld(&bar[XB_XGEN(b.x)]) == gen, bar);
            __builtin_amdgcn_fence(__ATOMIC_ACQUIRE, "agent");
            asm volatile("s_waitcnt vmcnt(0)" ::: "memory");
        }
    }
    __syncthreads();
}

struct Frame {
    LAS unsigned char* lds;
    gu32* ctl;
    int tid, lane, wave, vcu, G;
    float* out; unsigned char* ws;
};
typedef const float* cfp_t;
__device__ __forceinline__ cfp_t kin(int i) { const __attribute__((address_space(4))) cfp_t* ka = (const __attribute__((address_space(4))) cfp_t*)__builtin_amdgcn_kernarg_segment_ptr(); return ka[i]; }
enum { I_X = 0, I_P, I_GMIX, I_WIN, I_WDW, I_BDW, I_CLNG, I_CLNB, I_BCONV, I_BATTN, I_WOUT, I_GFFN, I_WGROUP, I_BGROUP, I_WER, I_BER, I_WGATE, I_WUP, I_WDOWN, I_GPLE, I_WPG, I_BPG, I_WPP, I_GFINAL };

__device__ __forceinline__ float wave_sum(float v) {
#pragma unroll
    for (int o = 1; o < 64; o <<= 1) v += __shfl_xor(v, o);
    return v;
}
__device__ __forceinline__ void tr_item(const float* src, int ld, int ks0, int ns0, const float* ksc, f16* dst, int dld, int nd0, int kd0, LAS float* scr, int lane) {
#pragma unroll 8
    for (int i = 0; i < 32; ++i) { const int kk = 2 * i + (lane >> 5); float v = src[(size_t)(ks0 + kk) * ld + ns0 + (lane & 31)]; if (ksc) v *= ksc[kk]; scr[kk * 33 + (lane & 31)] = v; }
    LDS_WAIT(); asm volatile("" ::: "memory");
    const int c = lane & 7;
#pragma unroll
    for (int j = 0; j < 4; ++j) { const int n = (lane >> 3) + 8 * j; const LAS float* s = scr + (8 * c) * 33 + n;
        u32x4 o; o.x = pkh(s[0 * 33], s[1 * 33]); o.y = pkh(s[2 * 33], s[3 * 33]); o.z = pkh(s[4 * 33], s[5 * 33]); o.w = pkh(s[6 * 33], s[7 * 33]);
        *(GAS u32x4*)(dst + (size_t)(nd0 + n) * dld + kd0 + 8 * c) = o; }
    LDS_WAIT(); asm volatile("" ::: "memory");
}
__device__ __forceinline__ void p0_prologue(Frame& F) {
    LAS float* scr = (LAS float*)(F.lds + RING_OFF + F.wave * 16384);
    const int gw = F.vcu * NWAVES + F.wave, NGW = F.G * NWAVES, lane = F.lane;
    unsigned char* ws = F.ws;
    constexpr int I1 = 16 * 80, I2 = 4 * 32, I3 = 16 * 32, I4 = 32 * 2 * 16 * 8, I5 = 32 * 4 * 32, I6 = 16 * 32;
    constexpr int NITEMS = I1 + I2 + I3 + I4 + I5 + I6;
    for (int it = gw; it < NITEMS; it += NGW) {
        int r = it;
        if (r < I1) { const int kb = r / 80, nb = r % 80, nd0 = 32 * nb; int ns0 = nd0;
            if (nd0 < 1024) { const int t = nd0 >> 8, j = nd0 & 255; ns0 = (j < 128) ? (128 * t + j) : (512 + 128 * t + (j - 128)); }
            tr_item(kin(I_WIN), NIN, 64 * kb, ns0, kin(I_GMIX) + 64 * kb, (f16*)(ws + WS_WIN), D, nd0, 64 * kb, scr, lane); continue; } r -= I1;
        if (r < I2) { const int kb = r / 32, nb = r % 32; tr_item(kin(I_WPP), D, 64 * kb, 32 * nb, nullptr, (f16*)(ws + WS_WPP), PLE, 32 * nb, 64 * kb, scr, lane); continue; } r -= I2;
        if (r < I3) { const int kb = r / 32, nb = r % 32, kd0 = 64 * kb, ks0 = (kd0 + 512) & 1023;
            tr_item(kin(I_WOUT), D, ks0, 32 * nb, (kd0 < 512) ? (kin(I_BATTN) + kd0) : nullptr, (f16*)(ws + WS_WOUT), D, 32 * nb, kd0, scr, lane); continue; } r -= I3;
        if (r < I4) { const int e = r / 256, q = r % 256, which = q / 128, kb = (q % 128) / 8, nbs = q % 8, ns0 = 32 * nbs;
            const int nd0 = 256 * (ns0 >> 7) + (which ? 128 : 0) + (ns0 & 127);
            tr_item(kin(which ? I_WUP : I_WGATE) + (size_t)e * D * DE, DE, 64 * kb, ns0, kin(I_GFFN) + 64 * kb, (f16*)(ws + WS_WGU) + (size_t)e * 512 * D, D, nd0, 64 * kb, scr, lane); continue; } r -= I4;
        if (r < I5) { const int e = r / 128, q = r % 128, kb = q / 32, nb = q % 32;
            tr_item(kin(I_WDOWN) + (size_t)e * DE * D, D, 64 * kb, 32 * nb, nullptr, (f16*)(ws + WS_WD) + (size_t)e * D * DE, DE, 32 * nb, 64 * kb, scr, lane); continue; } r -= I5;
        { const int kb = r / 32, nb = r % 32; tr_item(kin(I_WPG), D, 64 * kb, 32 * nb, kin(I_GPLE) + 64 * kb, (f16*)(ws + WS_WPG), D, 32 * nb, 64 * kb, scr, lane); }
    }
    for (int m = gw; m < M; m += NGW) {
        const f32x4* xr = (const f32x4*)(kin(I_X) + (size_t)m * D) + lane;
        f32x4 v[4]; float s = 0.f;
#pragma unroll
        for (int j = 0; j < 4; ++j) { v[j] = xr[64 * j]; s += (v[j].x * v[j].x + v[j].y * v[j].y) + (v[j].z * v[j].z + v[j].w * v[j].w); }
        const float rs = __builtin_amdgcn_rsqf(wave_sum(s) * (1.f / D) + EPS);
        u32x2* o8 = (u32x2*)((f16*)(ws + WS_XN) + (size_t)m * D) + lane;
#pragma unroll
        for (int j = 0; j < 4; ++j) { u32x2 w; w.x = pkh(v[j].x * rs, v[j].y * rs); w.y = pkh(v[j].z * rs, v[j].w * rs); o8[64 * j] = w; }
    }
    { const f32x4* ps = (const f32x4*)kin(I_P); u32x2* pd = (u32x2*)(ws + WS_PH); const int gt = F.vcu * 512 + F.tid, NT = F.G * 512;
      for (int i = gt; i < M * PLE / 4; i += NT) { const f32x4 v = ps[i]; u32x2 w; w.x = pkh(v.x, v.y); w.y = pkh(v.z, v.w); pd[i] = w; } }
    { const int gt = F.vcu * 512 + F.tid, NT = F.G * 512;
      float* rope = (float*)(ws + WS_ROPE);
      for (int i = gt; i < S * 8; i += NT) { const int s = i >> 3, j = i & 7; const double inv = pow(500000.0, -(double)j / 8.0); const float ang = (float)s * (float)inv;
          rope[s * 16 + j] = (float)cos((double)ang); rope[s * 16 + 8 + j] = (float)sin((double)ang); }
      int* mtok = (int*)(ws + WS_MTOK);
      for (int i = gt; i < SROWS; i += NT) mtok[i] = -1;
      float* wrf = (float*)(ws + WS_WRF);
      for (int i = gt; i < 64 * 3 * 64 * 4; i += NT) { const int t = i & 3, ln = (i >> 2) & 63, q = i >> 8, nt = q % 3, ii = q / 3;
          const int k = 16 * ii + 4 * (ln >> 4) + t, n = 16 * nt + (ln & 15); float v = 0.f;
          if (n < 4) v = kin(I_WGROUP)[k * 4 + n]; else if (n < 36) { const int g = (n - 4) >> 3, e = (n - 4) & 7; v = kin(I_WER)[((size_t)g * D + k) * 8 + e]; }
          wrf[i] = v * kin(I_GFFN)[k]; } }
}

__device__ __forceinline__ float reduce16(float (&v)[16], int lane) {
    { const bool b = (lane & 32) != 0;
#pragma unroll
      for (int i = 0; i < 8; ++i) { const float send = b ? v[i] : v[i + 8], keep = b ? v[i + 8] : v[i]; v[i] = keep + __shfl_xor(send, 32); } }
    { const bool b = (lane & 16) != 0;
#pragma unroll
      for (int i = 0; i < 4; ++i) { const float send = b ? v[i] : v[i + 4], keep = b ? v[i + 4] : v[i]; v[i] = keep + __shfl_xor(send, 16); } }
    { const bool b = (lane & 8) != 0;
#pragma unroll
      for (int i = 0; i < 2; ++i) { const float send = b ? v[i] : v[i + 2], keep = b ? v[i + 2] : v[i]; v[i] = keep + __shfl_xor(send, 8); } }
    { const bool b = (lane & 4) != 0; const float send = b ? v[0] : v[1], keep = b ? v[1] : v[0]; v[0] = keep + __shfl_xor(send, 4); }
    v[0] += __shfl_xor(v[0], 2); v[0] += __shfl_xor(v[0], 1);
    return v[0];
}
__device__ __forceinline__ float reduce8(float (&v)[8], int lane) {
    { const bool b = (lane & 32) != 0;
#pragma unroll
      for (int i = 0; i < 4; ++i) { const float send = b ? v[i] : v[i + 4], keep = b ? v[i + 4] : v[i]; v[i] = keep + __shfl_xor(send, 32); } }
    { const bool b = (lane & 16) != 0;
#pragma unroll
      for (int i = 0; i < 2; ++i) { const float send = b ? v[i] : v[i + 2], keep = b ? v[i + 2] : v[i]; v[i] = keep + __shfl_xor(send, 16); } }
    { const bool b = (lane & 8) != 0; const float send = b ? v[0] : v[1], keep = b ? v[1] : v[0]; v[0] = keep + __shfl_xor(send, 8); }
    v[0] += __shfl_xor(v[0], 4); v[0] += __shfl_xor(v[0], 2); v[0] += __shfl_xor(v[0], 1);
    return v[0];
}

__device__ __forceinline__ void conv_phase(Frame& F) {
    const int tid = F.tid, lane = F.lane, half = tid >> 8, cp = tid & 255, c0 = 2 * cp, wv4 = (tid >> 6) & 3;
    const f16* U = (const f16*)(F.ws + WS_U); f16* MIX = (f16*)(F.ws + WS_MIX);
    float w0[31], w1[31];
#pragma unroll
    for (int w = 0; w < 31; ++w) { const f32x2 ww = *(const f32x2*)(kin(I_WDW) + w * CC + c0); w0[w] = ww.x; w1[w] = ww.y; }
    const f32x2 bd = *(const f32x2*)(kin(I_BDW) + c0), lg = *(const f32x2*)(kin(I_CLNG) + c0), lb = *(const f32x2*)(kin(I_CLNB) + c0), bc = *(const f32x2*)(kin(I_BCONV) + c0);
    LAS float* red = (LAS float*)(F.lds + RING_OFF);
    LAS float* red2 = red + 128;
    const int ntok_cu = M / F.G;
    for (int it = 0; it < ntok_cu / 16; ++it) {
        const int s0 = ntok_cu * F.vcu + (ntok_cu / 2) * half + 8 * it;
        const int bstart = s0 & ~(S - 1);
        float a0[8], a1[8];
#pragma unroll
        for (int j = 0; j < 8; ++j) { a0[j] = bd.x; a1[j] = bd.y; }
#pragma unroll
        for (int i = 0; i < 38; ++i) { const int row = s0 - 30 + i; float u0 = 0.f, u1 = 0.f;
            if (row >= bstart) { const f16x2 hv = *(const f16x2*)(U + (size_t)row * CC + c0); u0 = (float)hv.x; u1 = (float)hv.y; }
#pragma unroll
            for (int j = 0; j < 8; ++j) { const int w = i - j; if (w >= 0 && w <= 30) { a0[j] += u0 * w0[w]; a1[j] += u1 * w1[w]; } } }
        float st[16];
#pragma unroll
        for (int j = 0; j < 8; ++j) { st[j] = a0[j] + a1[j]; st[8 + j] = a0[j] * a0[j] + a1[j] * a1[j]; }
        { const float r = reduce16(st, lane); if ((lane & 3) == 0) { const int idx = 8 * ((lane >> 5) & 1) + 4 * ((lane >> 4) & 1) + 2 * ((lane >> 3) & 1) + ((lane >> 2) & 1); red[(half * 16 + idx) * 4 + wv4] = r; } }
        __syncthreads();
        float z0[8], z1[8], q[8];
#pragma unroll
        for (int j = 0; j < 8; ++j) { const f32x4 sa = *(const LAS f32x4*)(red + (half * 16 + j) * 4), sb = *(const LAS f32x4*)(red + (half * 16 + 8 + j) * 4);
            const float mean = ((sa[0] + sa[1]) + (sa[2] + sa[3])) * (1.f / CC), ex2 = ((sb[0] + sb[1]) + (sb[2] + sb[3])) * (1.f / CC);
            const float rstd = __builtin_amdgcn_rsqf(fmaxf(ex2 - mean * mean, 0.f) + EPS);
            const float y0 = (a0[j] - mean) * rstd * lg.x + lb.x, y1 = (a1[j] - mean) * rstd * lg.y + lb.y;
            z0[j] = y0 * sigmoidf_(y0); z1[j] = y1 * sigmoidf_(y1); q[j] = z0[j] * z0[j] + z1[j] * z1[j]; }
        { const float r = reduce8(q, lane); if ((lane & 7) == 0) { const int idx = 4 * ((lane >> 5) & 1) + 2 * ((lane >> 4) & 1) + ((lane >> 3) & 1); red2[(half * 8 + idx) * 4 + wv4] = r; } }
        __syncthreads();
#pragma unroll
        for (int j = 0; j < 8; ++j) { const f32x4 sa = *(const LAS f32x4*)(red2 + (half * 8 + j) * 4);
            const float rs = __builtin_amdgcn_rsqf(((sa[0] + sa[1]) + (sa[2] + sa[3])) * (1.f / CC) + EPS);
            *(unsigned*)(MIX + (size_t)(s0 + j) * D + CC + c0) = pkh(z0[j] * rs * bc.x, z1[j] * rs * bc.y); }
    }
    __syncthreads();
}

__device__ __forceinline__ void router_phase(Frame& F) {
    const int lane = F.lane, wave = F.wave, r = lane & 15, g = lane >> 4;
    const float* x1 = F.out; const float* wrf = (const float*)(F.ws + WS_WRF);
    LAS float* lg = (LAS float*)(F.lds + RING_OFF) + wave * (16 * 48 + 16);
    LAS int* lcnt = (LAS int*)(F.lds + RING_OFF + 32768);
    int* re = (int*)(F.ws + WS_RE); float* rw = (float*)(F.ws + WS_RW); int* rpos = (int*)(F.ws + WS_RPOS); float* rs2 = (float*)(F.ws + WS_RS2);
    const int NGW = F.G * NWAVES;
    for (int wt0 = 0; wt0 < M / 16; wt0 += NGW) {
        const int wt = wt0 + F.vcu * NWAVES + wave; const bool live = wt < M / 16;
        if (F.tid < 32) lcnt[F.tid] = 0;
        __syncthreads();
        int e1 = 0, e2 = 0, r1 = 0, r2 = 0; float w1 = 0.f, w2 = 0.f, rsv = 0.f;
        if (live) {
            const float* xr = x1 + (size_t)(16 * wt + r) * D + 4 * g;
            f32x4 acc[3]; acc[0] = (f32x4){0.f, 0.f, 0.f, 0.f}; acc[1] = acc[0]; acc[2] = acc[0]; float ss = 0.f;
#pragma unroll 4
            for (int i = 0; i < 64; ++i) { const f32x4 a = *(const f32x4*)(xr + 16 * i); ss += (a[0] * a[0] + a[1] * a[1]) + (a[2] * a[2] + a[3] * a[3]);
#pragma unroll
                for (int nt = 0; nt < 3; ++nt) { const f32x4 bw = *(const f32x4*)(wrf + ((size_t)(i * 3 + nt) * 64 + lane) * 4);
#pragma unroll
                    for (int t = 0; t < 4; ++t) acc[nt] = __builtin_amdgcn_mfma_f32_16x16x4f32(a[t], bw[t], acc[nt], 0, 0, 0); } }
            ss += __shfl_xor(ss, 16); ss += __shfl_xor(ss, 32);
            const float rs = __builtin_amdgcn_rsqf(ss * (1.f / D) + EPS);
#pragma unroll
            for (int nt = 0; nt < 3; ++nt)
#pragma unroll
                for (int q = 0; q < 4; ++q) lg[(4 * g + q) * 48 + 16 * nt + r] = acc[nt][q];
            if (g == 0) lg[16 * 48 + r] = rs;
            LDS_WAIT();
            if (lane < 16) {
                const LAS float* l = lg + lane * 48; rsv = lg[16 * 48 + lane];
                float gl[4]; int gi = 0; float gm;
#pragma unroll
                for (int q = 0; q < 4; ++q) gl[q] = l[q] * rsv + kin(I_BGROUP)[q];
                gm = gl[0];
#pragma unroll
                for (int q = 1; q < 4; ++q) if (gl[q] > gm) { gm = gl[q]; gi = q; }
                float den = 0.f;
#pragma unroll
                for (int q = 0; q < 4; ++q) den += __expf(gl[q] - gm);
                const float gw = 1.0f / den;
                float el[8];
#pragma unroll
                for (int q = 0; q < 8; ++q) el[q] = l[4 + 8 * gi + q] * rsv + kin(I_BER)[gi * 8 + q];
                int i1 = 0; float v1 = el[0];
#pragma unroll
                for (int q = 1; q < 8; ++q) if (el[q] > v1) { v1 = el[q]; i1 = q; }
                int i2 = -1; float v2 = -INFINITY;
#pragma unroll
                for (int q = 0; q < 8; ++q) if (q != i1 && el[q] > v2) { v2 = el[q]; i2 = q; }
                const float ex = __expf(v2 - v1); w1 = gw / (1.0f + ex); w2 = gw * ex / (1.0f + ex);
                e1 = gi * 8 + i1; e2 = gi * 8 + i2;
                r1 = atomicAdd((int*)&lcnt[e1], 1); r2 = atomicAdd((int*)&lcnt[e2], 1);
            }
        }
        __syncthreads();
        if (F.tid < 32) { const int c = lcnt[F.tid]; int base = 0; if (c > 0) base = (int)__hip_atomic_fetch_add((unsigned*)(F.ctl + CW_CNT + 64 * F.tid), (unsigned)c, RLX_AGENT); lcnt[32 + F.tid] = base; }
        __syncthreads();
        if (live && lane < 16) { const int tk = 16 * wt + lane;
            re[tk * 2] = e1; re[tk * 2 + 1] = e2; rw[tk * 2] = w1; rw[tk * 2 + 1] = w2; rpos[tk * 2] = lcnt[32 + e1] + r1; rpos[tk * 2 + 1] = lcnt[32 + e2] + r2; rs2[tk] = rsv; }
        __syncthreads();
    }
}
__device__ __forceinline__ int moe_tiles(Frame& F) {
    LAS int* texp = (LAS int*)(F.lds + MISC_OFF + 4096); LAS int* tb = (LAS int*)(F.lds + MISC_OFF + 6144);
    if (F.tid == 0) { int acc = 0; for (int e = 0; e < NE; ++e) { tb[e] = acc; const int c = (int)__hip_atomic_load((unsigned*)(F.ctl + CW_CNT + 64 * e), RLX_AGENT); acc += (c + 255) >> 8; } tb[NE] = acc; }
    __syncthreads();
    const int nt = __builtin_amdgcn_readfirstlane(tb[NE]);
    for (int t = F.tid; t < nt; t += 512) { int e = 0; for (int q = 1; q < NE; ++q) if (tb[q] <= t) e = q; texp[t] = e; }
    __syncthreads();
    return nt;
}
__device__ __forceinline__ void gather_phase(Frame& F) {
    (void)moe_tiles(F);
    const LAS int* tb = (const LAS int*)(F.lds + MISC_OFF + 6144);
    const int gw = F.vcu * NWAVES + F.wave, NGW = F.G * NWAVES, lane = F.lane;
    const int* re = (const int*)(F.ws + WS_RE); const float* rw = (const float*)(F.ws + WS_RW); const int* rpos = (const int*)(F.ws + WS_RPOS); const float* rs2 = (const float*)(F.ws + WS_RS2);
    const f16* x1h = (const f16*)(F.ws + WS_XN); f16* Xs = (f16*)(F.ws + WS_XS);
    int* mtok = (int*)(F.ws + WS_MTOK); float* mw = (float*)(F.ws + WS_MW); float* mrs = (float*)(F.ws + WS_MRS);
    for (int tk = gw; tk < M; tk += NGW) {
        const u32x4 a = *(const u32x4*)(x1h + (size_t)tk * D + lane * 8), b = *(const u32x4*)(x1h + (size_t)tk * D + 512 + lane * 8);
        const float rs = rs2[tk];
#pragma unroll
        for (int sl = 0; sl < 2; ++sl) { const int e = re[tk * 2 + sl], srow = tb[e] * 256 + rpos[tk * 2 + sl];
            *(u32x4*)(Xs + (size_t)srow * D + lane * 8) = a; *(u32x4*)(Xs + (size_t)srow * D + 512 + lane * 8) = b;
            if (lane == 0) { mtok[srow] = tk * 2 + sl; mw[srow] = rw[tk * 2 + sl]; mrs[srow] = rs; } }
    }
}
__device__ __forceinline__ void combine_phase(Frame& F) {
    const int gw = F.vcu * NWAVES + F.wave, NGW = F.G * NWAVES, lane = F.lane;
    const f16* Y = (const f16*)(F.ws + WS_Y); f16* x2n = (f16*)(F.ws + WS_XN);
    for (int m = gw; m < M; m += NGW) {
        f32x4* xr = (f32x4*)(F.out + (size_t)m * D) + lane;
        const f16x4* y0 = (const f16x4*)(Y + (size_t)m * D) + lane; const f16x4* y1 = (const f16x4*)(Y + ((size_t)M + m) * D) + lane;
        f32x4 v[4]; float s = 0.f;
#pragma unroll
        for (int j = 0; j < 4; ++j) { v[j] = xr[64 * j]; const f16x4 a = y0[64 * j], b = y1[64 * j];
            v[j].x += (float)a[0] + (float)b[0]; v[j].y += (float)a[1] + (float)b[1]; v[j].z += (float)a[2] + (float)b[2]; v[j].w += (float)a[3] + (float)b[3];
            s += (v[j].x * v[j].x + v[j].y * v[j].y) + (v[j].z * v[j].z + v[j].w * v[j].w); xr[64 * j] = v[j]; }
        const float rs = __builtin_amdgcn_rsqf(wave_sum(s) * (1.f / D) + EPS);
        u32x2* o8 = (u32x2*)(x2n + (size_t)m * D) + lane;
#pragma unroll
        for (int j = 0; j < 4; ++j) { u32x2 w; w.x = pkh(v[j].x * rs, v[j].y * rs); w.y = pkh(v[j].z * rs, v[j].w * rs); o8[64 * j] = w; }
    }
}
__device__ __forceinline__ void final_phase(Frame& F) {
    const int gw = F.vcu * NWAVES + F.wave, NGW = F.G * NWAVES, lane = F.lane;
    const float* ssqf = (const float*)(F.ws + WS_SSQF);
    f32x4 gf[4];
#pragma unroll
    for (int j = 0; j < 4; ++j) gf[j] = ((const f32x4*)kin(I_GFINAL))[lane + 64 * j];
    for (int m = gw; m < M; m += NGW) {
        const f32x4* sp = (const f32x4*)(ssqf + (size_t)m * 16); const f32x4 s0 = sp[0], s1 = sp[1], s2 = sp[2], s3 = sp[3];
        const float s = (((s0[0] + s0[1]) + (s0[2] + s0[3])) + ((s1[0] + s1[1]) + (s1[2] + s1[3]))) + (((s2[0] + s2[1]) + (s2[2] + s2[3])) + ((s3[0] + s3[1]) + (s3[2] + s3[3])));
        const float rs = __builtin_amdgcn_rsqf(s * (1.f / D) + EPS);
        f32x4* xr = (f32x4*)(F.out + (size_t)m * D) + lane;
#pragma unroll
        for (int j = 0; j < 4; ++j) { f32x4 v = xr[64 * j]; v = v * rs * gf[j]; xr[64 * j] = v; }
    }
}

#ifndef MK_PER_PHASE
#define MK_PER_PHASE 0
#endif
constexpr int NPHASE = 11;
struct Args { const float* in[24]; float* out; unsigned char* ws; int ph_lo, ph_hi; };
__global__ void __launch_bounds__(NWAVES * 64, 2) fwd_kernel(Args args) {
    extern __shared__ __attribute__((aligned(16))) unsigned char lds[];
    Frame F;
    F.lds = (LAS unsigned char*)lds;
    F.tid = threadIdx.x; F.lane = F.tid & 63; F.wave = __builtin_amdgcn_readfirstlane(F.tid >> 6);
    F.G = gridDim.x; { const int bx = blockIdx.x; F.vcu = (F.G % 8 == 0) ? (bx % 8) * (F.G / 8) + bx / 8 : bx; }
    unsigned char* ws = args.ws; F.ws = ws; F.out = args.out;
    F.ctl = (gu32*)(ws + WS_CTL);
    volatile LAS unsigned* MISC = (volatile LAS unsigned*)(F.lds + MISC_OFF);
    for (int u = F.tid; u < 128; u += NWAVES * 64) MISC[u] = 0u;
    __syncthreads();
    XcdBarrier bar; bar.bar = (unsigned*)(F.ctl + CW_BAR); bar.x = 0; bar.st = nullptr;
    if (!MK_PER_PHASE) bar = xcd_barrier_post((unsigned*)(F.ctl + CW_BAR), MISC + 8);
    const int lo = args.ph_lo, hi = args.ph_hi;
#ifndef PH_MASK
#define PH_MASK 0x7ff
#endif
#define IN(k) (((PH_MASK >> (k)) & 1) && lo <= (k) && (k) < hi)
#define SEAM(k) do { if (lo <= (k) && (k) + 1 < hi) xcd_barrier(bar); } while (0)
    LAS unsigned char* ring = F.lds + RING_OFF; LAS unsigned char* misc = F.lds + MISC_OFF;
#define PHASE_FENCE() do { int t_ = threadIdx.x; asm volatile("" : "+v"(t_) :: "memory"); F.tid = t_; F.lane = t_ & 63; } while (0)

    if (IN(0)) { PHASE_FENCE(); p0_prologue(F); } SEAM(0);

    if (IN(1)) {
        { pg8::Gemm g{(const f16*)(ws + WS_XN), (const f16*)(ws + WS_WIN), D}; pg8::StaticOrder So; So.init(M, NIN, F.G, (int)blockIdx.x);
          pg8::Epi1 E{(f16*)(ws + WS_U), (f16*)(ws + WS_Q), (f16*)(ws + WS_K), (f16*)(ws + WS_V), (const float*)(ws + WS_ROPE), (float*)(ws + WS_KPART)};
          pg8::gemm_phase<pg8::Epi1, pg8::StaticOrder, true>(ring, misc, g, So, E); }
        { pg8::Gemm g{(const f16*)(ws + WS_PH), (const f16*)(ws + WS_WPP), PLE}; pg8::StaticOrder So; So.init(M, D, F.G, (int)blockIdx.x);
          pg8::EpiH E{(f16*)(ws + WS_PP), D};
          pg8::gemm_phase<pg8::EpiH, pg8::StaticOrder, true>(ring, misc, g, So, E); }
    } SEAM(1);

    if (IN(2)) {
        PHASE_FENCE();
        for (int i = 0; i < 4; ++i) {
            const int bh = F.vcu >> 1, s2 = (F.vcu & 1) * 2 + (i >> 1), qb = (i & 1) ? 7 - s2 : s2;
            if (bh < NB * NH)
                att::unit<8>(bh / NH, bh % NH, qb, (const f16*)(ws + WS_Q), (const f16*)(ws + WS_K), (const f16*)(ws + WS_V), (f16*)(ws + WS_MIX), (float*)(ws + WS_SSQA), (const float*)(ws + WS_KPART), (char*)lds + RING_OFF, F.tid);
        }
        PHASE_FENCE();
        conv_phase(F);
    } SEAM(2);

    if (IN(3)) {
        pg8::Gemm g{(const f16*)(ws + WS_MIX), (const f16*)(ws + WS_WOUT), D}; pg8::StaticOrder So; So.init(M, D, F.G, (int)blockIdx.x);
        pg8::Epi2 E{kin(I_X), F.out, (f16*)(ws + WS_XN), (const float*)(ws + WS_SSQA)};
        pg8::gemm_phase<pg8::Epi2, pg8::StaticOrder, true>(ring, misc, g, So, E);
    } SEAM(3);

    if (IN(4)) { PHASE_FENCE(); router_phase(F); } SEAM(4);
    if (IN(5)) { PHASE_FENCE(); gather_phase(F); } SEAM(5);

    if (IN(6)) {
        PHASE_FENCE();
        const int ntl = moe_tiles(F);
        pg8::Gemm g{(const f16*)(ws + WS_XS), (const f16*)(ws + WS_WGU), D};
        pg8::MoeOrder So{ntl, 2, F.G, F.vcu, (const LAS int*)(F.lds + MISC_OFF + 4096)};
        pg8::EpiGU E{(f16*)(ws + WS_HS), (const float*)(ws + WS_MRS), (const float*)(ws + WS_MW)};
        pg8::gemm_phase<pg8::EpiGU, pg8::MoeOrder, true>(ring, misc, g, So, E);
    } SEAM(6);

    if (IN(7)) {
        PHASE_FENCE();
        const int ntl = moe_tiles(F);
        pg8::Gemm g{(const f16*)(ws + WS_HS), (const f16*)(ws + WS_WD), DE};
        pg8::MoeOrder So{ntl, 4, F.G, F.vcu, (const LAS int*)(F.lds + MISC_OFF + 4096)};
        pg8::EpiDN E{(f16*)(ws + WS_Y), (const int*)(ws + WS_MTOK)};
        pg8::gemm_phase<pg8::EpiDN, pg8::MoeOrder, true>(ring, misc, g, So, E);
    } SEAM(7);

    if (IN(8)) { PHASE_FENCE(); combine_phase(F); } SEAM(8);

    if (IN(9)) {
        pg8::Gemm g{(const f16*)(ws + WS_XN), (const f16*)(ws + WS_WPG), D}; pg8::StaticOrder So; So.init(M, D, F.G, (int)blockIdx.x);
        pg8::EpiPLE E{F.out, (const f16*)(ws + WS_PP), kin(I_BPG), (float*)(ws + WS_SSQF)};
        pg8::gemm_phase<pg8::EpiPLE, pg8::StaticOrder, true>(ring, misc, g, So, E);
    } SEAM(9);

    if (IN(10)) { PHASE_FENCE(); final_phase(F); }
#undef IN
#undef SEAM
}

extern "C" void kernel_launch(void* const* d_in, const int* in_sizes, int n_in, void* d_out, int out_size, void* d_ws, size_t ws_size, hipStream_t stream) {
    static int grid = 0;
    if (grid == 0) {
        if (n_in != 24 || in_sizes[0] != M * D || out_size != M * D || ws_size < WS_END) { fprintf(stderr, "kernel_launch: unexpected shapes (n_in %d, in0 %d, out %d, ws %zu); nothing launched\n", n_in, n_in > 0 ? in_sizes[0] : -1, out_size, ws_size); grid = -1; return; }
        int dev = 0, cus = 0, per_cu = 0;
        if (hipGetDevice(&dev) != hipSuccess || hipDeviceGetAttribute(&cus, hipDeviceAttributeMultiprocessorCount, dev) != hipSuccess) { grid = -1; return; }
        if (hipFuncSetAttribute((const void*)fwd_kernel, hipFuncAttributeMaxDynamicSharedMemorySize, LDS_BYTES) != hipSuccess) { fprintf(stderr, "kernel_launch: hipFuncSetAttribute failed\n"); grid = -1; return; }
        if (hipOccupancyMaxActiveBlocksPerMultiprocessor(&per_cu, (const void*)fwd_kernel, NWAVES * 64, LDS_BYTES) != hipSuccess || per_cu < 1) fprintf(stderr, "kernel_launch: occupancy query reports %d\n", per_cu);
        (void)hipGetLastError();
        grid = cus;
        if (grid != 256) fprintf(stderr, "kernel_launch: %d CUs; this kernel is laid out for 256\n", grid);
    }
    if (grid < 0) return;
    (void)hipMemsetAsync((char*)d_ws + WS_CTL, 0, CTL_ZERO_BYTES, stream);
    Args a{};
    for (int i = 0; i < 24; ++i) a.in[i] = (const float*)d_in[i];
    a.out = (float*)d_out; a.ws = (unsigned char*)d_ws;
#if MK_PER_PHASE
    for (int p = 0; p < NPHASE; ++p) { a.ph_lo = p; a.ph_hi = p + 1; hipLaunchKernelGGL(fwd_kernel, dim3(grid), dim3(NWAVES * 64), LDS_BYTES, stream, a); }
#else
    a.ph_lo = 0; a.ph_hi = NPHASE;
    hipLaunchKernelGGL(fwd_kernel, dim3(grid), dim3(NWAVES * 64), LDS_BYTES, stream, a);
#endif
}
```

```cpp
#include <hip/hip_runtime.h>
#include <cstdio>
#include <cstdint>
#include <cmath>

#define GAS __attribute__((address_space(1)))
#define LAS __attribute__((address_space(3)))
typedef _Float16 f16;
typedef _Float16 f16x2 __attribute__((ext_vector_type(2)));
typedef _Float16 f16x4 __attribute__((ext_vector_type(4)));
typedef _Float16 f16x8 __attribute__((ext_vector_type(8)));
typedef short s16x4 __attribute__((ext_vector_type(4)));
typedef short s16x8 __attribute__((ext_vector_type(8)));
typedef float f32x2 __attribute__((ext_vector_type(2)));
typedef float f32x4 __attribute__((ext_vector_type(4)));
typedef float f32x16 __attribute__((ext_vector_type(16)));
typedef unsigned u32x2 __attribute__((ext_vector_type(2)));
typedef unsigned u32x4 __attribute__((ext_vector_type(4)));

__device__ __forceinline__ unsigned pkh(float lo, float hi) { f16x2 h; h.x = (f16)lo; h.y = (f16)hi; return __builtin_bit_cast(unsigned, h); }
__device__ __forceinline__ float sigmoidf_(float v) { return __builtin_amdgcn_rcpf(1.0f + __builtin_amdgcn_exp2f(-1.4426950408889634f * v)); }

constexpr int NB = 16, S = 2048, D = 1024, M = NB * S;
constexpr int CC = 512, AW = 512, NH = 8, HD = 64, NIN = 2560, NE = 32, DE = 256, PLE = 256;
constexpr float EPS = 1e-6f;
constexpr int MAXT = 288;
constexpr int SROWS = MAXT * 256;

namespace pg8 {
#define PG8_LAS __attribute__((address_space(3)))
constexpr int BM = 256, BK = 64, HALF = 128, HTB = HALF * BK * 2, STAGE_BYTES = 8 * HTB, NXCD = 8, WGM = 8;
__host__ __device__ __forceinline__ int lds_byte(int r, int c) { const int st = (r >> 4) * 2 + (c >> 5), rr = r & 15, cc = c & 31, ob = rr * 64 + cc * 2; return st * 1024 + (ob ^ (((ob >> 9) & 1) << 5)); }
__host__ __device__ __forceinline__ void stage_rc(int b, int& R, int& C) { const int st = b / 1024, sb = b % 1024, swz = sb ^ (((sb >> 9) & 1) << 5); R = (st >> 1) * 16 + swz / 64; C = (st & 1) * 32 + (swz % 64) / 2; }
__host__ __device__ __forceinline__ int perm32(int rho) { const int n = rho >> 4, i = rho & 15; return 8 * (i >> 2) + 4 * n + (i & 3); }

struct Unit { int pm, pn; };
struct Gemm { const f16* A; const f16* Bt; int K; };

struct StaticOrder {
    int nM, nN, nwg, G, c;
    __device__ void init(int M_, int N_, int G_, int c_) { nM = M_ / BM; nN = N_ / BM; nwg = nM * nN; G = G_; c = c_; }
    __device__ bool next(int i, Unit& u) const {
        const long L = (long)i * G + c; if (L >= nwg) return false;
        int wgid = (int)L; { const int q = nwg / NXCD, r = nwg % NXCD, xcd = wgid % NXCD, off = wgid / NXCD; wgid = (xcd < r ? xcd * (q + 1) : r * (q + 1) + (xcd - r) * q) + off; }
        const int nig = WGM * nN, gid = wgid / nig, fm = gid * WGM, gsz = (nM - fm) < WGM ? (nM - fm) : WGM;
        u.pm = fm + ((wgid % nig) % gsz); u.pn = (wgid % nig) / gsz; return true;
    }
};
struct MoeOrder {
    int ntiles, nper, G, vcu; const LAS int* texp;
    __device__ bool next(int i, Unit& u) const {
        const int L = i * G + vcu; if (L >= ntiles * nper) return false;
        u.pm = L / nper; u.pn = __builtin_amdgcn_readfirstlane(texp[u.pm]) * nper + (L % nper); return true;
    }
};

template <class Epi, class Sched, bool ALIGN_EPI>
__device__ __forceinline__ void gemm_phase(PG8_LAS unsigned char* lds, PG8_LAS unsigned char* misc, const Gemm g, const Sched& S, const Epi& E) {
    int tid = threadIdx.x; asm volatile("" : "+v"(tid) :: "memory");
    const int wid = __builtin_amdgcn_readfirstlane(tid >> 6), lane = tid & 63, wr = wid >> 2, wc = wid & 3, fr = lane & 15, fq = lane >> 4;
    const int K = g.K, nt = K / BK;
    unsigned voffA[2], voffB[2];
#pragma unroll
    for (int i = 0; i < 2; ++i) { int R, C; stage_rc(tid * 16 + i * 8192, R, C); const int Rb = Epi::PERM ? ((R & ~31) + perm32(R & 31)) : R;
        voffA[i] = (unsigned)(R * K + C) * 2u; voffB[i] = (unsigned)(Rb * K + C) * 2u; }
    const size_t kstep = (size_t)(BK * 2);
    const size_t hstep = (size_t)HALF * K * 2;
    const size_t tstep = 2 * hstep;
    const unsigned ldsw = (unsigned)wid * 1024u;
    const int aoff = lds_byte(wr * 64 + fr, fq * 8), boff = lds_byte(wc * 32 + fr, fq * 8);
#define PG8_SA(b, h) (((b) * 2 + (h)) * HTB)
#define PG8_SB(b, h) ((4 + (b) * 2 + (h)) * HTB)
#define PG8_STAGE(bufoff, gbase, voff) do { _Pragma("unroll") for (int _i = 0; _i < 2; ++_i) \
        __builtin_amdgcn_global_load_lds((const unsigned*)((const char*)(gbase) + (voff)[_i]), (PG8_LAS unsigned*)(lds + (bufoff) + ldsw + _i * 8192), 16, 0, 0); } while (0)
#define PG8_LDA(dst, b, h) do { _Pragma("unroll") for (int m = 0; m < 4; ++m) _Pragma("unroll") for (int k = 0; k < 2; ++k) dst[m][k] = *(const PG8_LAS f16x8*)(lds + PG8_SA(b, h) + aoff + m * 2048 + k * 1024); } while (0)
#define PG8_LDB(dst, b, h) do { _Pragma("unroll") for (int n = 0; n < 2; ++n) _Pragma("unroll") for (int k = 0; k < 2; ++k) dst[n][k] = *(const PG8_LAS f16x8*)(lds + PG8_SB(b, h) + boff + n * 2048 + k * 1024); } while (0)
#define PG8_MMA(ai, bj, At, Bt) do { __builtin_amdgcn_s_setprio(1); _Pragma("unroll") for (int m = 0; m < 4; ++m) _Pragma("unroll") for (int n = 0; n < 2; ++n) _Pragma("unroll") for (int k = 0; k < 2; ++k) \
        acc[ai][bj][m][n] = __builtin_amdgcn_mfma_f32_16x16x32_f16(Bt[n][k], At[m][k], acc[ai][bj][m][n], 0, 0, 0); __builtin_amdgcn_s_setprio(0); } while (0)
#define PG8_WAIT_V(n) asm volatile("s_waitcnt vmcnt(" #n ")" ::: "memory")
#define PG8_WAIT_L(n) asm volatile("s_waitcnt lgkmcnt(" #n ")" ::: "memory")
#define PG8_BAR __builtin_amdgcn_s_barrier()
#define PG8_SCHED __builtin_amdgcn_sched_barrier(0)
    Unit cur, nxt; int ui = 0;
    if (!S.next(0, cur)) return;
    f32x4 acc[2][2][4][2];
#pragma unroll
    for (int a = 0; a < 2; ++a)
#pragma unroll
        for (int b = 0; b < 2; ++b)
#pragma unroll
            for (int m = 0; m < 4; ++m)
#pragma unroll
                for (int n = 0; n < 2; ++n) acc[a][b][m][n] = (f32x4){0.f, 0.f, 0.f, 0.f};
    f16x8 At[4][2], B0[2][2], B1[2][2];
    const char* cA = (const char*)g.A + (size_t)cur.pm * tstep; const char* cB = (const char*)g.Bt + (size_t)cur.pn * tstep;
    if constexpr (Epi::MIDSCALE) E.unit_begin(cur, ui, misc, tid);
    PG8_STAGE(PG8_SB(0, 0), cB, voffB); PG8_STAGE(PG8_SB(0, 1), cB + hstep, voffB); PG8_STAGE(PG8_SA(0, 0), cA, voffA); PG8_STAGE(PG8_SA(0, 1), cA + hstep, voffA);
    if (wr == 1) PG8_BAR;
    PG8_WAIT_V(2); PG8_BAR;
    PG8_STAGE(PG8_SB(1, 0), cB + kstep, voffB); PG8_STAGE(PG8_SA(1, 0), cA + kstep, voffA); PG8_STAGE(PG8_SB(1, 1), cB + hstep + kstep, voffB);
    PG8_WAIT_V(6); PG8_BAR;
    for (;;) {
        const bool has_next = S.next(ui + 1, nxt);
        const char* nA = has_next ? (const char*)g.A + (size_t)nxt.pm * tstep : cA; const char* nB = has_next ? (const char*)g.Bt + (size_t)nxt.pn * tstep : cB;
#pragma nounroll
        for (int t = 0; t < nt; t += 2) {
            const bool last = (t == nt - 2);
            const char* a1 = cA + (size_t)(t + 1) * kstep;
            const char* a2 = last ? nA : cA + (size_t)(t + 2) * kstep; const char* b2 = last ? nB : cB + (size_t)(t + 2) * kstep;
            const char* a3 = a2 + kstep; const char* b3 = b2 + kstep;
            if constexpr (Epi::MIDSCALE) { if (t == (nt >> 1)) E.midscale(acc, ui, wr, fr, misc); }
            PG8_LDB(B0, 0, 0); PG8_LDB(B1, 0, 1); PG8_SCHED; PG8_LDA(At, 0, 0); PG8_STAGE(PG8_SA(1, 1), a1 + hstep, voffA);
            PG8_WAIT_V(8); PG8_WAIT_L(0); PG8_BAR; PG8_MMA(0, 0, At, B0); PG8_MMA(0, 1, At, B1); PG8_BAR; PG8_SCHED;
            PG8_LDA(At, 0, 1); PG8_STAGE(PG8_SB(0, 0), b2, voffB); PG8_STAGE(PG8_SB(0, 1), b2 + hstep, voffB); PG8_STAGE(PG8_SA(0, 0), a2, voffA);
            PG8_WAIT_V(8); PG8_WAIT_L(0); PG8_BAR; PG8_MMA(1, 0, At, B0); PG8_MMA(1, 1, At, B1); PG8_BAR; PG8_SCHED;
            PG8_LDB(B0, 1, 0); PG8_LDB(B1, 1, 1); PG8_SCHED; PG8_LDA(At, 1, 0); PG8_STAGE(PG8_SA(0, 1), a2 + hstep, voffA);
            PG8_WAIT_V(8); PG8_WAIT_L(0); PG8_BAR; PG8_MMA(0, 0, At, B0); PG8_MMA(0, 1, At, B1); PG8_BAR; PG8_SCHED;
            PG8_LDA(At, 1, 1); PG8_STAGE(PG8_SB(1, 0), b3, voffB); PG8_STAGE(PG8_SB(1, 1), b3 + hstep, voffB); PG8_STAGE(PG8_SA(1, 0), a3, voffA);
            PG8_WAIT_V(8); PG8_WAIT_L(0); PG8_BAR; PG8_MMA(1, 0, At, B0); PG8_MMA(1, 1, At, B1); PG8_BAR; PG8_SCHED;
        }
        if constexpr (ALIGN_EPI) { if (wr == 0) PG8_BAR; }
        { int l2 = threadIdx.x; asm volatile("" : "+v"(l2)); l2 &= 63; E(acc, cur, wr, wc, l2 & 15, l2 >> 4); }
        if (!has_next) break;
#pragma unroll
        for (int a = 0; a < 2; ++a)
#pragma unroll
            for (int b = 0; b < 2; ++b)
#pragma unroll
                for (int m = 0; m < 4; ++m)
#pragma unroll
                    for (int n = 0; n < 2; ++n) acc[a][b][m][n] = (f32x4){0.f, 0.f, 0.f, 0.f};
        cur = nxt; cA = nA; cB = nB; ++ui;
        if constexpr (Epi::MIDSCALE) E.unit_begin(cur, ui, misc, tid);
        if constexpr (ALIGN_EPI) { if (wr == 1) PG8_BAR; }
    }
    PG8_WAIT_V(0);
    if constexpr (!ALIGN_EPI) { if (wr == 0) PG8_BAR; }
    PG8_BAR;
#undef PG8_SA
#undef PG8_SB
#undef PG8_STAGE
#undef PG8_LDA
#undef PG8_LDB
#undef PG8_MMA
#undef PG8_WAIT_V
#undef PG8_WAIT_L
#undef PG8_BAR
#undef PG8_SCHED
}

constexpr float C2 = 0.125f * 1.4426950408889634f;
struct Epi1 {
    static constexpr bool PERM = true, MIDSCALE = false;
    f16 *U, *Q, *Kb, *V; const float* rope; float* kpart;
    template <bool ROT> __device__ __forceinline__ void qk_tile(const f32x4 (&acc)[2][2][4][2], const Unit& u, int row0, int cl, int fr, int fq, int wr) const {
        const bool isq = u.pn < 6; char* dst = (char*)(isq ? Q : Kb); const int cb = (u.pn & 1) * 256; const float sc = isq ? C2 : 1.0f;
        const float sgn = (fq == 0) ? -1.0f : ((fq == 1) ? 1.0f : 0.0f); const bool lowq = fq < 2;
#pragma unroll
        for (int bj = 0; bj < 2; ++bj) {
            f32x4 cs0 = (f32x4){0.f, 0.f, 0.f, 0.f}, cs1 = cs0;
#pragma unroll
            for (int ai = 0; ai < 2; ++ai)
#pragma unroll
                for (int m = 0; m < 4; ++m) { const int row = row0 + ai * HALF + m * 16;
                    f32x4 v0 = acc[ai][bj][m][0], v1 = acc[ai][bj][m][1];
                    if (ROT) { const float* rp = rope + (unsigned)(row & (S - 1)) * 16u;
                        f32x4 c0 = *(const f32x4*)(rp), c1 = *(const f32x4*)(rp + 4); const f32x4 s0 = *(const f32x4*)(rp + 8) * sgn, s1 = *(const f32x4*)(rp + 12) * sgn;
#pragma unroll
                        for (int e = 0; e < 4; ++e) { c0[e] = lowq ? c0[e] : 1.0f; c1[e] = lowq ? c1[e] : 1.0f; }
                        f32x4 p0, p1;
#pragma unroll
                        for (int e = 0; e < 4; ++e) { p0[e] = __shfl_xor(v0[e], 16); p1[e] = __shfl_xor(v1[e], 16); }
                        v0 = v0 * c0 + p0 * s0; v1 = v1 * c1 + p1 * s1; }
                    v0 = v0 * sc; v1 = v1 * sc;
                    u32x4 w; w.x = pkh(v0[0], v0[1]); w.y = pkh(v0[2], v0[3]); w.z = pkh(v1[0], v1[1]); w.w = pkh(v1[2], v1[3]);
                    *(u32x4*)(dst + ((unsigned)row * (unsigned)AW + (unsigned)(cb + bj * HALF + cl)) * 2u) = w;
                    cs0 += v0; cs1 += v1; asm volatile("" : "+v"(cs0), "+v"(cs1) :: "memory"); }
            if (!isq) {
#pragma unroll
                for (int e = 0; e < 4; ++e) { float v = cs0[e]; v += __shfl_xor(v, 1); v += __shfl_xor(v, 2); v += __shfl_xor(v, 4); v += __shfl_xor(v, 8); cs0[e] = v;
                    float y = cs1[e]; y += __shfl_xor(y, 1); y += __shfl_xor(y, 2); y += __shfl_xor(y, 4); y += __shfl_xor(y, 8); cs1[e] = y; }
                if (fr == 0) { float* kp = kpart + (unsigned)(wr * 128 + u.pm) * (unsigned)AW + (unsigned)(cb + bj * HALF + cl); *(f32x4*)kp = cs0; *(f32x4*)(kp + 4) = cs1; }
            }
        }
    }
    __device__ __forceinline__ void operator()(const f32x4 (&acc)[2][2][4][2], const Unit& u, int wr, int wc, int fr, int fq) const {
        const int row0 = u.pm * BM + wr * 64 + fr, cl = wc * 32 + 8 * fq;
        if (u.pn < 4) {
#pragma unroll
            for (int ai = 0; ai < 2; ++ai)
#pragma unroll
                for (int m = 0; m < 4; ++m) { const size_t row = (size_t)(row0 + ai * HALF + m * 16);
                    const f32x4 v0 = acc[ai][0][m][0], v1 = acc[ai][0][m][1], g0 = acc[ai][1][m][0], g1 = acc[ai][1][m][1];
                    u32x4 w; w.x = pkh(v0[0] * sigmoidf_(g0[0]), v0[1] * sigmoidf_(g0[1])); w.y = pkh(v0[2] * sigmoidf_(g0[2]), v0[3] * sigmoidf_(g0[3]));
                    w.z = pkh(v1[0] * sigmoidf_(g1[0]), v1[1] * sigmoidf_(g1[1])); w.w = pkh(v1[2] * sigmoidf_(g1[2]), v1[3] * sigmoidf_(g1[3]));
                    *(u32x4*)(U + row * CC + u.pn * 128 + cl) = w; asm volatile("" ::: "memory"); }
        } else if (u.pn < 8) {
            if ((wc & 1) == 0) qk_tile<true>(acc, u, row0, cl, fr, fq, wr); else qk_tile<false>(acc, u, row0, cl, fr, fq, wr);
        } else {
            const int cb = (u.pn & 1) * 256;
#pragma unroll
            for (int ai = 0; ai < 2; ++ai)
#pragma unroll
                for (int m = 0; m < 4; ++m) { const size_t row = (size_t)(row0 + ai * HALF + m * 16);
#pragma unroll
                    for (int bj = 0; bj < 2; ++bj) { const f32x4 v0 = acc[ai][bj][m][0], v1 = acc[ai][bj][m][1];
                        u32x4 w; w.x = pkh(v0[0], v0[1]); w.y = pkh(v0[2], v0[3]); w.z = pkh(v1[0], v1[1]); w.w = pkh(v1[2], v1[3]);
                        *(u32x4*)(V + row * AW + cb + bj * HALF + cl) = w; } }
        }
    }
};
struct EpiH {
    static constexpr bool PERM = true, MIDSCALE = false;
    f16* O; int ldc;
    __device__ __forceinline__ void operator()(const f32x4 (&acc)[2][2][4][2], const Unit& u, int wr, int wc, int fr, int fq) const {
        const int row0 = u.pm * BM + wr * 64 + fr, col0 = u.pn * BM + wc * 32 + 8 * fq;
#pragma unroll
        for (int ai = 0; ai < 2; ++ai)
#pragma unroll
            for (int m = 0; m < 4; ++m) { f16* rp = O + (size_t)(row0 + ai * HALF + m * 16) * ldc + col0;
#pragma unroll
                for (int bj = 0; bj < 2; ++bj) { const f32x4 v0 = acc[ai][bj][m][0], v1 = acc[ai][bj][m][1];
                    u32x4 w; w.x = pkh(v0[0], v0[1]); w.y = pkh(v0[2], v0[3]); w.z = pkh(v1[0], v1[1]); w.w = pkh(v1[2], v1[3]);
                    *(u32x4*)(rp + bj * HALF) = w; } }
    }
};
struct Epi2 {
    static constexpr bool PERM = true, MIDSCALE = true;
    const float* x; float* x1; f16* x1h; const float* ssqa;
    __device__ __forceinline__ void unit_begin(const Unit& u, int ui, PG8_LAS unsigned char* misc, int tid) const {
        if (tid < 256) { const float* p = ssqa + (size_t)(u.pm * BM + tid) * 8; const f32x4 a = *(const f32x4*)p, b = *(const f32x4*)(p + 4);
            const float s = ((a[0] + a[1]) + (a[2] + a[3])) + ((b[0] + b[1]) + (b[2] + b[3]));
            ((PG8_LAS float*)(misc + 512))[(ui & 1) * 256 + tid] = __builtin_amdgcn_rsqf(s * (1.0f / AW) + EPS); }
    }
    __device__ __forceinline__ void midscale(f32x4 (&acc)[2][2][4][2], int ui, int wr, int fr, PG8_LAS unsigned char* misc) const {
        const PG8_LAS float* rb = (const PG8_LAS float*)(misc + 512) + (ui & 1) * 256 + wr * 64 + fr;
#pragma unroll
        for (int ai = 0; ai < 2; ++ai)
#pragma unroll
            for (int m = 0; m < 4; ++m) { const float s = rb[ai * HALF + m * 16];
#pragma unroll
                for (int bj = 0; bj < 2; ++bj)
#pragma unroll
                    for (int n = 0; n < 2; ++n) acc[ai][bj][m][n] = acc[ai][bj][m][n] * s; }
    }
    __device__ __forceinline__ void operator()(const f32x4 (&acc)[2][2][4][2], const Unit& u, int wr, int wc, int fr, int fq) const {
        const int row0 = u.pm * BM + wr * 64 + fr, col0 = u.pn * BM + wc * 32 + 8 * fq;
#pragma unroll
        for (int ai = 0; ai < 2; ++ai)
#pragma unroll
            for (int m = 0; m < 4; ++m) { const size_t off = (size_t)(row0 + ai * HALF + m * 16) * D + col0;
#pragma unroll
                for (int bj = 0; bj < 2; ++bj) { const f32x4 v0 = acc[ai][bj][m][0] + *(const f32x4*)(x + off + bj * HALF), v1 = acc[ai][bj][m][1] + *(const f32x4*)(x + off + bj * HALF + 4);
                    *(f32x4*)(x1 + off + bj * HALF) = v0; *(f32x4*)(x1 + off + bj * HALF + 4) = v1;
                    u32x4 w; w.x = pkh(v0[0], v0[1]); w.y = pkh(v0[2], v0[3]); w.z = pkh(v1[0], v1[1]); w.w = pkh(v1[2], v1[3]);
                    *(u32x4*)(x1h + off + bj * HALF) = w; } asm volatile("" ::: "memory"); }
    }
};
struct EpiGU {
    static constexpr bool PERM = true, MIDSCALE = false;
    f16* Hs; const float* mRs; const float* mW;
    __device__ __forceinline__ void operator()(const f32x4 (&acc)[2][2][4][2], const Unit& u, int wr, int wc, int fr, int fq) const {
        const int row0 = u.pm * BM + wr * 64 + fr, col0 = (u.pn & 1) * 128 + wc * 32 + 8 * fq;
#pragma unroll
        for (int ai = 0; ai < 2; ++ai)
#pragma unroll
            for (int m = 0; m < 4; ++m) { const int row = row0 + ai * HALF + m * 16; const float rs = mRs[row], wt = mW[row] * rs;
                float h[8];
#pragma unroll
                for (int n = 0; n < 2; ++n)
#pragma unroll
                    for (int e = 0; e < 4; ++e) { const float gg = acc[ai][0][m][n][e] * rs, uu = acc[ai][1][m][n][e] * wt; h[n * 4 + e] = gg * sigmoidf_(gg) * uu; }
                u32x4 w; w.x = pkh(h[0], h[1]); w.y = pkh(h[2], h[3]); w.z = pkh(h[4], h[5]); w.w = pkh(h[6], h[7]);
                *(u32x4*)(Hs + (size_t)row * DE + col0) = w; asm volatile("" ::: "memory"); }
    }
};
struct EpiDN {
    static constexpr bool PERM = true, MIDSCALE = false;
    f16* Y; const int* mTok;
    __device__ __forceinline__ void operator()(const f32x4 (&acc)[2][2][4][2], const Unit& u, int wr, int wc, int fr, int fq) const {
        const int row0 = u.pm * BM + wr * 64 + fr, col0 = (u.pn & 3) * BM + wc * 32 + 8 * fq;
#pragma unroll
        for (int ai = 0; ai < 2; ++ai)
#pragma unroll
            for (int m = 0; m < 4; ++m) { const int t2 = mTok[row0 + ai * HALF + m * 16];
                if (t2 >= 0) { const unsigned off = (((unsigned)(t2 & 1) * (unsigned)M + (unsigned)(t2 >> 1)) * (unsigned)D + (unsigned)col0) * 2u;
#pragma unroll
                    for (int bj = 0; bj < 2; ++bj) { const f32x4 v0 = acc[ai][bj][m][0], v1 = acc[ai][bj][m][1];
                        u32x4 w; w.x = pkh(v0[0], v0[1]); w.y = pkh(v0[2], v0[3]); w.z = pkh(v1[0], v1[1]); w.w = pkh(v1[2], v1[3]);
                        *(u32x4*)((char*)Y + off + bj * HALF * 2) = w; } } }
    }
};
struct EpiPLE {
    static constexpr bool PERM = true, MIDSCALE = false;
    float* xio; const f16* PP; const float* bias; float* ssqf;
    __device__ __forceinline__ void operator()(const f32x4 (&acc)[2][2][4][2], const Unit& u, int wr, int wc, int fr, int fq) const {
        const int row0 = u.pm * BM + wr * 64 + fr, col0 = u.pn * BM + wc * 32 + 8 * fq;
        f32x4 bv[2][2];
#pragma unroll
        for (int bj = 0; bj < 2; ++bj) { bv[bj][0] = *(const f32x4*)(bias + col0 + bj * HALF); bv[bj][1] = *(const f32x4*)(bias + col0 + bj * HALF + 4); }
#pragma unroll
        for (int ai = 0; ai < 2; ++ai)
#pragma unroll
            for (int m = 0; m < 4; ++m) { const int row = row0 + ai * HALF + m * 16; const size_t off = (size_t)row * D + col0; float ss = 0.f;
#pragma unroll
                for (int bj = 0; bj < 2; ++bj) { const f16x8 pp = *(const f16x8*)(PP + off + bj * HALF);
                    f32x4 x0 = *(const f32x4*)(xio + off + bj * HALF), x1 = *(const f32x4*)(xio + off + bj * HALF + 4);
#pragma unroll
                    for (int e = 0; e < 4; ++e) { x0[e] += (float)pp[e] * sigmoidf_(acc[ai][bj][m][0][e] + bv[bj][0][e]); x1[e] += (float)pp[4 + e] * sigmoidf_(acc[ai][bj][m][1][e] + bv[bj][1][e]); }
                    *(f32x4*)(xio + off + bj * HALF) = x0; *(f32x4*)(xio + off + bj * HALF + 4) = x1;
                    ss += (x0[0] * x0[0] + x0[1] * x0[1]) + (x0[2] * x0[2] + x0[3] * x0[3]) + (x1[0] * x1[0] + x1[1] * x1[1]) + (x1[2] * x1[2] + x1[3] * x1[3]); }
                ss += __shfl_xor(ss, 16); ss += __shfl_xor(ss, 32);
                if (fq == 0) ssqf[(size_t)row * 16 + u.pn * 4 + wc] = ss; asm volatile("" ::: "memory"); }
    }
};
}

namespace att {
constexpr int NSLOT = 3, SLOTB = 8192;
constexpr int L_K = 0, L_V = NSLOT * SLOTB, L_WS = 2 * NSLOT * SLOTB, L_OST = L_WS + 8 * 64 * 4, L_KM = L_OST + 8 * 4096, L_END = L_KM + 8 * 64 * 4;
__device__ __forceinline__ int crow(int r, int hi) { return (r & 3) + 8 * (r >> 2) + 4 * hi; }
#define ATT_SBAR() __builtin_amdgcn_sched_barrier(0)
#define ATT_WAIT_BAR(N) asm volatile("s_waitcnt vmcnt(" #N ") lgkmcnt(0)\n\ts_barrier" ::: "memory")
__device__ __forceinline__ void glds16(const void* gsrc, unsigned lds_dst) { unsigned keep;
    asm volatile("s_mov_b32 %0, m0\n\ts_mov_b32 m0, %2\n\ts_nop 0\n\tglobal_load_lds_dwordx4 %1, off\n\ts_mov_b32 m0, %0" : "=&s"(keep) : "v"(gsrc), "s"(lds_dst) : "memory"); }
__device__ __forceinline__ void qkt(f32x16& p0, f32x16& p1, const char* Kslot, const f16x8* qr, const f32x16& negm, int r32, int hi) {
    const char* kb = Kslot + hi * 1024 + r32 * 16;
#pragma unroll
    for (int d0 = 0; d0 < 4; ++d0) {
        const f16x8 b0 = *reinterpret_cast<const f16x8*>(kb + d0 * 2048);
        const f16x8 b1 = *reinterpret_cast<const f16x8*>(kb + d0 * 2048 + 512);
        if (d0 == 0) { p0 = __builtin_amdgcn_mfma_f32_32x32x16_f16(b0, qr[0], negm, 0, 0, 0); p1 = __builtin_amdgcn_mfma_f32_32x32x16_f16(b1, qr[0], negm, 0, 0, 0); }
        else { p0 = __builtin_amdgcn_mfma_f32_32x32x16_f16(b0, qr[d0], p0, 0, 0, 0); p1 = __builtin_amdgcn_mfma_f32_32x32x16_f16(b1, qr[d0], p1, 0, 0, 0); } }
}
__device__ __forceinline__ float rowmax(const f32x16& p0, const f32x16& p1) {
    float a = fmaxf(p0[0], p1[0]);
#pragma unroll
    for (int r = 1; r < 16; ++r) a = fmaxf(a, fmaxf(p0[r], p1[r]));
    auto rr = __builtin_amdgcn_permlane32_swap(__float_as_uint(a), __float_as_uint(a), false, false);
    return fmaxf(__uint_as_float(rr[0]), __uint_as_float(rr[1]));
}
__device__ __forceinline__ void pv(f32x16* o, int vb, f16x8 pa0, f16x8 pa1, f16x8 pa2, f16x8 pa3) {
#pragma unroll
    for (int d0 = 0; d0 < 2; ++d0) { s16x4 lo[4], hi[4];
#pragma unroll
        for (int ks = 0; ks < 4; ++ks) {
            asm volatile("ds_read_b64_tr_b16 %0,%1 offset:%c2" : "=&v"(lo[ks]) : "v"(vb), "i"(d0 * 4096 + ks * 1024) : "memory");
            asm volatile("ds_read_b64_tr_b16 %0,%1 offset:%c2" : "=&v"(hi[ks]) : "v"(vb), "i"(d0 * 4096 + ks * 1024 + 512) : "memory"); }
        asm volatile("s_waitcnt lgkmcnt(0)" ::: "memory"); ATT_SBAR();
#define ATT_PK(k) __builtin_bit_cast(f16x8, (s16x8){lo[k][0], lo[k][1], lo[k][2], lo[k][3], hi[k][0], hi[k][1], hi[k][2], hi[k][3]})
        o[d0] = __builtin_amdgcn_mfma_f32_32x32x16_f16(pa0, ATT_PK(0), o[d0], 0, 0, 0);
        o[d0] = __builtin_amdgcn_mfma_f32_32x32x16_f16(pa1, ATT_PK(1), o[d0], 0, 0, 0);
        o[d0] = __builtin_amdgcn_mfma_f32_32x32x16_f16(pa2, ATT_PK(2), o[d0], 0, 0, 0);
        o[d0] = __builtin_amdgcn_mfma_f32_32x32x16_f16(pa3, ATT_PK(3), o[d0], 0, 0, 0);
#undef ATT_PK
    }
}
template <int THRL> __device__ __forceinline__ void unit(int b, int h, int qb, const f16* Q, const f16* __restrict__ K, const f16* __restrict__ V, f16* O, float* ssqa, const float* kpart, char* shm, int tid) {
    const int lane = tid & 63, r32 = lane & 31, hi = lane >> 5; const int wid = __builtin_amdgcn_readfirstlane(tid >> 6);
    const long rowbase = (long)b * S; const int q0 = qb * 256;
    const f16* Qw = Q + (rowbase + q0 + wid * 32) * AW + h * HD;
    const f16* Kh = K + rowbase * AW + h * HD; const f16* Vh = V + rowbase * AW + h * HD;
    const unsigned lds0 = (unsigned)(uintptr_t)shm;
    float* wsf = (float*)(shm + L_WS) + wid * 64;
    float* km = (float*)(shm + L_KM);
    { const int n = tid >> 6, d = tid & 63; float v = 0.f;
      if (n < qb) { const size_t o = (size_t)(b * 8 + n) * AW + h * HD + d; v = (kpart[o] + kpart[(size_t)128 * AW + o]) * (1.0f / 256.0f); }
      km[tid] = v; }
    const f16* ksrc = Kh + (long)lane * AW + wid * 8;
    const f16* vsrc = Vh + (long)(16 * (wid & 3) + (lane >> 2)) * AW + (wid >> 2) * 32 + (lane & 3) * 8;
    const unsigned kdst = lds0 + L_K + wid * 1024, vdst = lds0 + L_V + wid * 1024;
#define ATT_KROW(t) ((t) < 4 ? (q0 + 64 * (t)) : 64 * ((t) - 4))
#define ATT_DMA_K(t, slot) glds16(ksrc + (long)ATT_KROW(t) * AW, (unsigned)__builtin_amdgcn_readfirstlane(kdst + (slot)))
#define ATT_DMA_V(t, slot) glds16(vsrc + (long)ATT_KROW(t) * AW, (unsigned)__builtin_amdgcn_readfirstlane(vdst + (slot)))
    const int vb0 = (int)(lds0 + L_V) + ((lane >> 4) & 1) * 32 + (lane & 3) * 8 + (4 * hi + ((lane & 15) >> 2)) * 64;
    const char* Kbase = shm + L_K;
    const int NT = 4 + 4 * qb;
    ATT_DMA_K(0, 0); ATT_DMA_V(0, 0);
    f16x8 qr[4];
#pragma unroll
    for (int d0 = 0; d0 < 4; ++d0) qr[d0] = *reinterpret_cast<const f16x8*>(&Qw[(long)r32 * AW + d0 * 16 + hi * 8]);
    asm volatile("s_waitcnt lgkmcnt(0)\n\ts_barrier" ::: "memory");
    unsigned sel = 0u;
    {
        float g[7];
#pragma unroll
        for (int n = 0; n < 7; ++n) g[n] = 0.f;
#pragma unroll
        for (int d0 = 0; d0 < 4; ++d0) {
            float qf[8];
#pragma unroll
            for (int j = 0; j < 8; ++j) qf[j] = (float)qr[d0][j];
#pragma unroll
            for (int n = 0; n < 7; ++n) { const f32x4 k0 = *(const f32x4*)(km + n * 64 + 16 * d0 + 8 * hi), k1 = *(const f32x4*)(km + n * 64 + 16 * d0 + 8 * hi + 4);
                g[n] += (qf[0] * k0[0] + qf[1] * k0[1]) + (qf[2] * k0[2] + qf[3] * k0[3]) + (qf[4] * k1[0] + qf[5] * k1[1]) + (qf[6] * k1[2] + qf[7] * k1[3]); }
            asm volatile("" ::: "memory");
        }
#pragma unroll
        for (int n = 0; n < 7; ++n) g[n] += __shfl_xor(g[n], 32);
        if (qb <= 3) sel = (1u << qb) - 1u;
        else {
#pragma unroll
            for (int n = 0; n < 7; ++n) { int rank = 0;
#pragma unroll
                for (int m2 = 0; m2 < 7; ++m2) if (m2 != n) rank += (m2 < qb && (g[m2] > g[n] || (g[m2] == g[n] && m2 < n))) ? 1 : 0;
                if (n < qb && rank < 3) sel |= 1u << n; }
        }
    }
    float mhat = 0.f, l_reg = 0.f; f32x16 o[2]; o[0] = f32x16{}; o[1] = f32x16{}; f32x16 negm = f32x16{};
    const int qrel = wid * 32 + r32;
    int slot = 0, nslot = SLOTB;
    for (int t = 0; t < NT; ++t) {
        if (t + 1 < NT) { ATT_DMA_K(t + 1, nslot); ATT_DMA_V(t + 1, nslot); ATT_WAIT_BAR(2); } else { ATT_WAIT_BAR(0); }
        const int pb = (t - 4) >> 2;
        const bool mine = (t < 4) ? true : (((sel >> pb) & 1u) != 0u);
        const bool active = (t < 4) ? (64 * t <= 32 * wid + 31) : (__any(mine ? 1 : 0) != 0);
        if (active) {
            f32x16 p0, p1;
            qkt(p0, p1, Kbase + slot, qr, negm, r32, hi);
            if (t < 4) { const int kb = 64 * t + 4 * hi;
#pragma unroll
                for (int r = 0; r < 16; ++r) { const int kv = kb + (r & 3) + 8 * (r >> 2); if (kv > qrel) p0[r] = -INFINITY; if (kv + 32 > qrel) p1[r] = -INFINITY; } }
            else if (!mine) {
#pragma unroll
                for (int r = 0; r < 16; ++r) { p0[r] = -INFINITY; p1[r] = -INFINITY; } }
            const float rm = rowmax(p0, p1);
            if (t == 0) { mhat = rm;
#pragma unroll
                for (int r = 0; r < 16; ++r) { p0[r] -= rm; p1[r] -= rm; negm[r] = -mhat; } }
            else if (__any(rm > (float)THRL)) { const float dl = fmaxf(rm, 0.f); mhat += dl;
#pragma unroll
                for (int r = 0; r < 16; ++r) { p0[r] -= dl; p1[r] -= dl; negm[r] = -mhat; }
                const float f = __builtin_amdgcn_exp2f(-dl); l_reg *= f; if (hi == 0) wsf[r32] = f;
                asm volatile("s_waitcnt lgkmcnt(0)" ::: "memory");
#pragma unroll
                for (int r = 0; r < 16; ++r) { const float fr_ = wsf[crow(r, hi)]; o[0][r] *= fr_; o[1][r] *= fr_; } }
            float sacc = 0.f;
#pragma unroll
            for (int r = 0; r < 16; ++r) { p0[r] = __builtin_amdgcn_exp2f(p0[r]); p1[r] = __builtin_amdgcn_exp2f(p1[r]); sacc += p0[r] + p1[r]; }
            l_reg += sacc;
            u32x4 pw0, pw1, pw2, pw3;
            pw0 = (u32x4){pkh(p0[0], p0[1]), pkh(p0[2], p0[3]), pkh(p0[4], p0[5]), pkh(p0[6], p0[7])};
            pw1 = (u32x4){pkh(p0[8], p0[9]), pkh(p0[10], p0[11]), pkh(p0[12], p0[13]), pkh(p0[14], p0[15])};
            pw2 = (u32x4){pkh(p1[0], p1[1]), pkh(p1[2], p1[3]), pkh(p1[4], p1[5]), pkh(p1[6], p1[7])};
            pw3 = (u32x4){pkh(p1[8], p1[9]), pkh(p1[10], p1[11]), pkh(p1[12], p1[13]), pkh(p1[14], p1[15])};
            pv(o, vb0 + slot, __builtin_bit_cast(f16x8, pw0), __builtin_bit_cast(f16x8, pw1), __builtin_bit_cast(f16x8, pw2), __builtin_bit_cast(f16x8, pw3));
        }
        slot = nslot; nslot = (nslot == (NSLOT - 1) * SLOTB) ? 0 : nslot + SLOTB;
    }
    { auto rr = __builtin_amdgcn_permlane32_swap(__float_as_uint(l_reg), __float_as_uint(l_reg), false, false); l_reg = __uint_as_float(rr[0]) + __uint_as_float(rr[1]); }
    if (hi == 0) wsf[32 + r32] = l_reg; asm volatile("s_waitcnt lgkmcnt(0)" ::: "memory");
    float rli[16];
#pragma unroll
    for (int r = 0; r < 16; ++r) rli[r] = __builtin_amdgcn_rcpf(wsf[32 + crow(r, hi)]);
    f16* Ow = O + (rowbase + q0 + wid * 32) * D + h * HD;
    { f16* stg = (f16*)(shm + L_OST) + wid * 2048;
#pragma unroll
      for (int r = 0; r < 16; ++r) { const int orow = crow(r, hi);
#pragma unroll
          for (int d0 = 0; d0 < 2; ++d0) stg[orow * 64 + d0 * 32 + r32] = (f16)(o[d0][r] * rli[r]); }
      asm volatile("s_waitcnt lgkmcnt(0)" ::: "memory");
#pragma unroll
      for (int i = 0; i < 4; ++i) { const int row = i * 8 + (lane >> 3), ch = lane & 7; const f16x8 v = *(const f16x8*)(stg + row * 64 + ch * 8);
          *(f16x8*)(Ow + (long)row * D + ch * 8) = v;
          float ss = 0.f;
#pragma unroll
          for (int e = 0; e < 8; ++e) { const float f = (float)v[e]; ss += f * f; }
          ss += __shfl_xor(ss, 1); ss += __shfl_xor(ss, 2); ss += __shfl_xor(ss, 4);
          if (ch == 0) ssqa[(size_t)(rowbase + q0 + wid * 32 + row) * 8 + h] = ss; } }
    asm volatile("s_waitcnt vmcnt(0) lgkmcnt(0)\n\ts_barrier" ::: "memory");
#undef ATT_KROW
#undef ATT_DMA_K
#undef ATT_DMA_V
}
}

constexpr size_t MiB = 1u << 20, KiB = 1u << 10;
constexpr size_t WS_CTL = 0, CTL_ZERO_BYTES = 1 * MiB;
constexpr size_t WS_ROPE = 1 * MiB;
constexpr size_t WS_KPART = 2 * MiB;
constexpr size_t WS_WRF = 3 * MiB;
constexpr size_t WS_SSQA = 4 * MiB;
constexpr size_t WS_SSQF = 5 * MiB;
constexpr size_t WS_RS2 = 7 * MiB;
constexpr size_t WS_RE = 7 * MiB + 128 * KiB;
constexpr size_t WS_RW = 7 * MiB + 384 * KiB;
constexpr size_t WS_RPOS = 7 * MiB + 640 * KiB;
constexpr size_t WS_MTOK = 8 * MiB;
constexpr size_t WS_MW = 8 * MiB + 320 * KiB;
constexpr size_t WS_MRS = 8 * MiB + 640 * KiB;
constexpr size_t WS_PH = 10 * MiB;
constexpr size_t WS_WIN = 26 * MiB, WS_WPP = 31 * MiB, WS_WOUT = 32 * MiB, WS_WPG = 34 * MiB, WS_WGU = 36 * MiB, WS_WD = 68 * MiB;
constexpr size_t WS_XN = 84 * MiB;
constexpr size_t WS_U = 148 * MiB, WS_Q = 180 * MiB, WS_K = 212 * MiB, WS_V = 244 * MiB;
constexpr size_t WS_MIX = 276 * MiB;
constexpr size_t WS_PP = 340 * MiB;
constexpr size_t WS_HS = 404 * MiB;
constexpr size_t WS_XS = 148 * MiB;
constexpr size_t WS_Y = 148 * MiB;
constexpr size_t WS_END = 440 * MiB;
static_assert(WS_XS + (size_t)SROWS * D * 2 <= WS_PP && WS_HS + (size_t)SROWS * DE * 2 <= WS_END && WS_MRS + SROWS * 4 <= 10 * MiB, "ws map");
constexpr int CW_CNT = 1024;
constexpr int CW_BAR = 4096;

constexpr int RING_OFF = 0, RING_BYTES = 131072;
constexpr int MISC_OFF = RING_BYTES;
constexpr int LDS_BYTES = 147456;
constexpr int NWAVES = 8;

typedef GAS unsigned gu32;
#define RLX_AGENT __ATOMIC_RELAXED, __HIP_MEMORY_SCOPE_AGENT
#define LDS_WAIT() asm volatile("s_waitcnt lgkmcnt(0)" ::: "memory")

#define XB_TMO      128
#define XB_XCNT(j)  (256  + 64 * (j))
#define XB_XSUB(j)  (1280 + 64 * (j))
#define XB_XGEN(j)  (2304 + 64 * (j))
#define XB_TOP      3328
#define XB_TOPGEN   3392
#define XB_SPIN_CAP (1u << 18)
__device__ __forceinline__ unsigned xb_ld(unsigned* p)              { return __hip_atomic_load(p, __ATOMIC_RELAXED, __HIP_MEMORY_SCOPE_AGENT); }
__device__ __forceinline__ unsigned xb_add(unsigned* p, unsigned v) { return __hip_atomic_fetch_add(p, v, __ATOMIC_RELAXED, __HIP_MEMORY_SCOPE_AGENT); }
__device__ __forceinline__ unsigned xb_xcc_id() { return (unsigned)__builtin_amdgcn_s_getreg((3 << 11) | 20) & 0xFu; }
#define XB_SPIN(cond, bar) do { unsigned _sp = 0; while (cond) { __builtin_amdgcn_s_sleep(1); \
    if ((++_sp & 255u) == 0u) { if (xb_ld(&(bar)[XB_TMO])) break; if (_sp > XB_SPIN_CAP) { atomicAdd(&(bar)[XB_TMO], 1u); break; } } } } while (0)
struct XcdBarrier { unsigned* bar; unsigned x; volatile LAS unsigned* st; };
__device__ __forceinline__ XcdBarrier xcd_barrier_post(unsigned* bar, volatile LAS unsigned* st) {
    XcdBarrier b; b.bar = bar; b.x = xb_xcc_id(); b.st = st;
    if (threadIdx.x == 0) (void)xb_add(&bar[XB_XCNT(b.x)], 1u);
    return b;
}
__device__ __forceinline__ void xcd_barrier_complete(unsigned* bar, unsigned x, unsigned& nloc, unsigned& nx) {
    const unsigned G = gridDim.x * gridDim.y * gridDim.z;
    unsigned sum, cnt, mine, sp = 0u;
    for (;;) {
        sum = 0u; cnt = 0u; mine = 0u;
#pragma unroll
        for (unsigned j = 0; j < 16; ++j) { const unsigned c = xb_ld(&bar[XB_XCNT(j)]); sum += c; cnt += (c > 0u) ? 1u : 0u; mine = (j == x) ? c : mine; }
        if (sum == G) break;
        __builtin_amdgcn_s_sleep(1);
        if ((++sp & 255u) == 0u) { if (xb_ld(&bar[XB_TMO])) break; if (sp > XB_SPIN_CAP) { atomicAdd(&bar[XB_TMO], 1u); break; } }
    }
    nloc = mine > 0u ? mine : 1u; nx = cnt > 0u ? cnt : 1u;
}
__device__ __forceinline__ void xcd_barrier(const XcdBarrier& b) {
    asm volatile("s_waitcnt vmcnt(0)" ::: "memory");
    __syncthreads();
    if (threadIdx.x == 0) {
        unsigned* bar = b.bar;
        __builtin_amdgcn_s_waitcnt(0);
        unsigned nloc = b.st[0], nx = b.st[1];
        if (nloc == 0u) { xcd_barrier_complete(bar, b.x, nloc, nx); b.st[0] = nloc; b.st[1] = nx; }
        const unsigned old = xb_add(&bar[XB_XSUB(b.x)], 1u);
        const unsigned gen = old / nloc;
        if (old + 1u == (gen + 1u) * nloc) {
            __builtin_amdgcn_fence(__ATOMIC_RELEASE, "agent");
            asm volatile("s_waitcnt vmcnt(0)" ::: "memory");
            const unsigned og = xb_add(&bar[XB_TOP], 1u);
            const unsigned tg = og / nx;
            if (og + 1u == (tg + 1u) * nx) xb_add(&bar[XB_TOPGEN], 1u);
            else XB_SPIN(xb_ld(&bar[XB_TOPGEN]) == tg, bar);
            __builtin_amdgcn_fence(__ATOMIC_ACQUIRE, "agent");
            xb_add(&bar[XB_XGEN(b.x)], 1u);
            asm volatile("s_waitcnt vmcnt(0)" ::: "memory");
        } else {
            XB_SPIN(xb_ld(&bar[XB_XGEN(b.x)]) == gen, bar);
            __builtin_amdgcn_fence(__ATOMIC_ACQUIRE, "agent");
            asm volatile("s_waitcnt vmcnt(0)" ::: "memory");
        }
    }
    __syncthreads();
}

struct Frame {
    LAS unsigned char* lds;
    gu32* ctl;
    int tid, lane, wave, vcu, G;
    float* out; unsigned char* ws;
};
typedef const float* cfp_t;
__device__ __forceinline__ cfp_t kin(int i) { const __attribute__((address_space(4))) cfp_t* ka = (const __attribute__((address_space(4))) cfp_t*)__builtin_amdgcn_kernarg_segment_ptr(); return ka[i]; }
enum { I_X = 0, I_P, I_GMIX, I_WIN, I_WDW, I_BDW, I_CLNG, I_CLNB, I_BCONV, I_BATTN, I_WOUT, I_GFFN, I_WGROUP, I_BGROUP, I_WER, I_BER, I_WGATE, I_WUP, I_WDOWN, I_GPLE, I_WPG, I_BPG, I_WPP, I_GFINAL };

__device__ __forceinline__ float wave_sum(float v) {
#pragma unroll
    for (int o = 1; o < 64; o <<= 1) v += __shfl_xor(v, o);
    return v;
}
__device__ __forceinline__ void tr_item(const float* src, int ld, int ks0, int ns0, const float* ksc, f16* dst, int dld, int nd0, int kd0, LAS float* scr, int lane) {
    const int kr = lane >> 4, n4 = (lane & 15) * 4;
#pragma unroll 4
    for (int i = 0; i < 16; ++i) { const int kk = 4 * i + kr; f32x4 v = *(const f32x4*)(src + (size_t)(ks0 + kk) * ld + ns0 + n4); if (ksc) v = v * ksc[kk];
        *(LAS f32x4*)(scr + kk * 64 + (n4 ^ (((kk >> 3) & 7) << 3))) = v; }
    LDS_WAIT(); asm volatile("" ::: "memory");
    const int c = lane & 7;
#pragma unroll
    for (int j = 0; j < 8; ++j) { const int n = (lane >> 3) + 8 * j; const LAS float* sp = scr + (8 * c) * 64 + (n ^ (c << 3));
        u32x4 o; o.x = pkh(sp[0 * 64], sp[1 * 64]); o.y = pkh(sp[2 * 64], sp[3 * 64]); o.z = pkh(sp[4 * 64], sp[5 * 64]); o.w = pkh(sp[6 * 64], sp[7 * 64]);
        *(GAS u32x4*)(dst + (size_t)(nd0 + n) * dld + kd0 + 8 * c) = o; }
    LDS_WAIT(); asm volatile("" ::: "memory");
}
__device__ __forceinline__ void p0_prologue(Frame& F) {
    LAS float* scr = (LAS float*)(F.lds + RING_OFF + F.wave * 16384);
    const int gw = F.vcu * NWAVES + F.wave, NGW = F.G * NWAVES, lane = F.lane;
    unsigned char* ws = F.ws;
    constexpr int I1 = 16 * 40, I2 = 4 * 16, I3 = 16 * 16, I4 = 32 * 2 * 16 * 4, I5 = 32 * 4 * 16, I6 = 16 * 16;
    constexpr int NITEMS = I1 + I2 + I3 + I4 + I5 + I6;
    for (int it = gw; it < NITEMS; it += NGW) {
        int r = it;
        if (r < I1) { const int kb = r / 40, nb = r % 40, nd0 = 64 * nb; int ns0 = nd0;
            if (nd0 < 1024) { const int t = nd0 >> 8, j = nd0 & 255; ns0 = (j < 128) ? (128 * t + j) : (512 + 128 * t + (j - 128)); }
            tr_item(kin(I_WIN), NIN, 64 * kb, ns0, kin(I_GMIX) + 64 * kb, (f16*)(ws + WS_WIN), D, nd0, 64 * kb, scr, lane); continue; } r -= I1;
        if (r < I2) { const int kb = r / 16, nb = r % 16; tr_item(kin(I_WPP), D, 64 * kb, 64 * nb, nullptr, (f16*)(ws + WS_WPP), PLE, 64 * nb, 64 * kb, scr, lane); continue; } r -= I2;
        if (r < I3) { const int kb = r / 16, nb = r % 16, kd0 = 64 * kb, ks0 = (kd0 + 512) & 1023;
            tr_item(kin(I_WOUT), D, ks0, 64 * nb, (kd0 < 512) ? (kin(I_BATTN) + kd0) : nullptr, (f16*)(ws + WS_WOUT), D, 64 * nb, kd0, scr, lane); continue; } r -= I3;
        if (r < I4) { const int e = r / 128, q = r % 128, which = q / 64, kb = (q % 64) / 4, nbs = q % 4, ns0 = 64 * nbs;
            const int nd0 = 256 * (ns0 >> 7) + (which ? 128 : 0) + (ns0 & 127);
            tr_item(kin(which ? I_WUP : I_WGATE) + (size_t)e * D * DE, DE, 64 * kb, ns0, kin(I_GFFN) + 64 * kb, (f16*)(ws + WS_WGU) + (size_t)e * 512 * D, D, nd0, 64 * kb, scr, lane); continue; } r -= I4;
        if (r < I5) { const int e = r / 64, q = r % 64, kb = q / 16, nb = q % 16;
            tr_item(kin(I_WDOWN) + (size_t)e * DE * D, D, 64 * kb, 64 * nb, nullptr, (f16*)(ws + WS_WD) + (size_t)e * D * DE, DE, 64 * nb, 64 * kb, scr, lane); continue; } r -= I5;
        { const int kb = r / 16, nb = r % 16; tr_item(kin(I_WPG), D, 64 * kb, 64 * nb, kin(I_GPLE) + 64 * kb, (f16*)(ws + WS_WPG), D, 64 * nb, 64 * kb, scr, lane); }
    }
    for (int m = gw; m < M; m += NGW) {
        const f32x4* xr = (const f32x4*)(kin(I_X) + (size_t)m * D) + lane;
        f32x4 v[4]; float s = 0.f;
#pragma unroll
        for (int j = 0; j < 4; ++j) { v[j] = xr[64 * j]; s += (v[j].x * v[j].x + v[j].y * v[j].y) + (v[j].z * v[j].z + v[j].w * v[j].w); }
        const float rs = __builtin_amdgcn_rsqf(wave_sum(s) * (1.f / D) + EPS);
        u32x2* o8 = (u32x2*)((f16*)(ws + WS_XN) + (size_t)m * D) + lane;
#pragma unroll
        for (int j = 0; j < 4; ++j) { u32x2 w; w.x = pkh(v[j].x * rs, v[j].y * rs); w.y = pkh(v[j].z * rs, v[j].w * rs); o8[64 * j] = w; }
    }
    { const f32x4* ps = (const f32x4*)kin(I_P); u32x2* pd = (u32x2*)(ws + WS_PH); const int gt = F.vcu * 512 + F.tid, NT = F.G * 512;
      for (int i = gt; i < M * PLE / 4; i += NT) { const f32x4 v = ps[i]; u32x2 w; w.x = pkh(v.x, v.y); w.y = pkh(v.z, v.w); pd[i] = w; } }
    { const int gt = F.vcu * 512 + F.tid, NT = F.G * 512;
      float* rope = (float*)(ws + WS_ROPE);
      for (int i = gt; i < S * 8; i += NT) { const int s = i >> 3, j = i & 7; const double inv = pow(500000.0, -(double)j / 8.0); const float ang = (float)s * (float)inv;
          rope[s * 16 + j] = (float)cos((double)ang); rope[s * 16 + 8 + j] = (float)sin((double)ang); }
      int* mtok = (int*)(ws + WS_MTOK);
      for (int i = gt; i < SROWS; i += NT) mtok[i] = -1;
      float* wrf = (float*)(ws + WS_WRF);
      for (int i = gt; i < 64 * 3 * 64 * 4; i += NT) { const int t = i & 3, ln = (i >> 2) & 63, q = i >> 8, nt = q % 3, ii = q / 3;
          const int k = 16 * ii + 4 * (ln >> 4) + t, n = 16 * nt + (ln & 15); float v = 0.f;
          if (n < 4) v = kin(I_WGROUP)[k * 4 + n]; else if (n < 36) { const int g = (n - 4) >> 3, e = (n - 4) & 7; v = kin(I_WER)[((size_t)g * D + k) * 8 + e]; }
          wrf[i] = v * kin(I_GFFN)[k]; } }
}

__device__ __forceinline__ float reduce16(float (&v)[16], int lane) {
    { const bool b = (lane & 32) != 0;
#pragma unroll
      for (int i = 0; i < 8; ++i) { const float send = b ? v[i] : v[i + 8], keep = b ? v[i + 8] : v[i]; v[i] = keep + __shfl_xor(send, 32); } }
    { const bool b = (lane & 16) != 0;
#pragma unroll
      for (int i = 0; i < 4; ++i) { const float send = b ? v[i] : v[i + 4], keep = b ? v[i + 4] : v[i]; v[i] = keep + __shfl_xor(send, 16); } }
    { const bool b = (lane & 8) != 0;
#pragma unroll
      for (int i = 0; i < 2; ++i) { const float send = b ? v[i] : v[i + 2], keep = b ? v[i + 2] : v[i]; v[i] = keep + __shfl_xor(send, 8); } }
    { const bool b = (lane & 4) != 0; const float send = b ? v[0] : v[1], keep = b ? v[1] : v[0]; v[0] = keep + __shfl_xor(send, 4); }
    v[0] += __shfl_xor(v[0], 2); v[0] += __shfl_xor(v[0], 1);
    return v[0];
}
__device__ __forceinline__ float reduce8(float (&v)[8], int lane) {
    { const bool b = (lane & 32) != 0;
#pragma unroll
      for (int i = 0; i < 4; ++i) { const float send = b ? v[i] : v[i + 4], keep = b ? v[i + 4] : v[i]; v[i] = keep + __shfl_xor(send, 32); } }
    { const bool b = (lane & 16) != 0;
#pragma unroll
      for (int i = 0; i < 2; ++i) { const float send = b ? v[i] : v[i + 2], keep = b ? v[i + 2] : v[i]; v[i] = keep + __shfl_xor(send, 16); } }
    { const bool b = (lane & 8) != 0; const float send = b ? v[0] : v[1], keep = b ? v[1] : v[0]; v[0] = keep + __shfl_xor(send, 8); }
    v[0] += __shfl_xor(v[0], 4); v[0] += __shfl_xor(v[0], 2); v[0] += __shfl_xor(v[0], 1);
    return v[0];
}

__device__ __forceinline__ void conv_phase(Frame& F) {
    const int tid = F.tid, lane = F.lane, half = tid >> 8, cp = tid & 255, c0 = 2 * cp, wv4 = (tid >> 6) & 3;
    const f16* U = (const f16*)(F.ws + WS_U); f16* MIX = (f16*)(F.ws + WS_MIX);
    float w0[31], w1[31];
#pragma unroll
    for (int w = 0; w < 31; ++w) { const f32x2 ww = *(const f32x2*)(kin(I_WDW) + w * CC + c0); w0[w] = ww.x; w1[w] = ww.y; }
    const f32x2 bd = *(const f32x2*)(kin(I_BDW) + c0), lg = *(const f32x2*)(kin(I_CLNG) + c0), lb = *(const f32x2*)(kin(I_CLNB) + c0), bc = *(const f32x2*)(kin(I_BCONV) + c0);
    LAS float* red = (LAS float*)(F.lds + RING_OFF);
    LAS float* red2 = red + 128;
    LAS unsigned char* ust = F.lds + RING_OFF + 4096;
    const int ntok_cu = M / F.G;
    for (int it8 = 0; it8 < ntok_cu / 16; ++it8) {
        const int grp = it8 >> 2, it = it8 & 3;
        const int s0g = ntok_cu * F.vcu + 64 * grp, bstart = s0g & ~(S - 1);
        if (it == 0) {
            __syncthreads();
            u32x4 rv[12];
#pragma unroll
            for (int q = 0; q < 12; ++q) { const int r = F.wave + 8 * q, row = s0g - 30 + r; rv[q] = (u32x4){0u, 0u, 0u, 0u};
                if (r < 94 && row >= bstart) rv[q] = *(const u32x4*)(U + (size_t)row * CC + lane * 8); }
#pragma unroll
            for (int q = 0; q < 12; ++q) { const int r = F.wave + 8 * q; if (r < 94) *(LAS u32x4*)(ust + r * 1024 + lane * 16) = rv[q]; }
            __syncthreads();
        }
        const int s0 = s0g + 32 * half + 8 * it;
        float a0[8], a1[8];
#pragma unroll
        for (int j = 0; j < 8; ++j) { a0[j] = bd.x; a1[j] = bd.y; }
        { const LAS unsigned char* up = ust + (32 * half + 8 * it) * 1024 + cp * 4;
#pragma unroll
          for (int i = 0; i < 38; ++i) { const f16x2 hv = *(const LAS f16x2*)(up + i * 1024); const float u0 = (float)hv.x, u1 = (float)hv.y;
#pragma unroll
              for (int j = 0; j < 8; ++j) { const int w = i - j; if (w >= 0 && w <= 30) { a0[j] += u0 * w0[w]; a1[j] += u1 * w1[w]; } } } }
        float st[16];
#pragma unroll
        for (int j = 0; j < 8; ++j) { st[j] = a0[j] + a1[j]; st[8 + j] = a0[j] * a0[j] + a1[j] * a1[j]; }
        { const float r = reduce16(st, lane); if ((lane & 3) == 0) { const int idx = 8 * ((lane >> 5) & 1) + 4 * ((lane >> 4) & 1) + 2 * ((lane >> 3) & 1) + ((lane >> 2) & 1); red[(half * 16 + idx) * 4 + wv4] = r; } }
        __syncthreads();
        float z0[8], z1[8], q[8];
#pragma unroll
        for (int j = 0; j < 8; ++j) { const f32x4 sa = *(const LAS f32x4*)(red + (half * 16 + j) * 4), sb = *(const LAS f32x4*)(red + (half * 16 + 8 + j) * 4);
            const float mean = ((sa[0] + sa[1]) + (sa[2] + sa[3])) * (1.f / CC), ex2 = ((sb[0] + sb[1]) + (sb[2] + sb[3])) * (1.f / CC);
            const float rstd = __builtin_amdgcn_rsqf(fmaxf(ex2 - mean * mean, 0.f) + EPS);
            const float y0 = (a0[j] - mean) * rstd * lg.x + lb.x, y1 = (a1[j] - mean) * rstd * lg.y + lb.y;
            z0[j] = y0 * sigmoidf_(y0); z1[j] = y1 * sigmoidf_(y1); q[j] = z0[j] * z0[j] + z1[j] * z1[j]; }
        { const float r = reduce8(q, lane); if ((lane & 7) == 0) { const int idx = 4 * ((lane >> 5) & 1) + 2 * ((lane >> 4) & 1) + ((lane >> 3) & 1); red2[(half * 8 + idx) * 4 + wv4] = r; } }
        __syncthreads();
#pragma unroll
        for (int j = 0; j < 8; ++j) { const f32x4 sa = *(const LAS f32x4*)(red2 + (half * 8 + j) * 4);
            const float rs = __builtin_amdgcn_rsqf(((sa[0] + sa[1]) + (sa[2] + sa[3])) * (1.f / CC) + EPS);
            *(unsigned*)(MIX + (size_t)(s0 + j) * D + CC + c0) = pkh(z0[j] * rs * bc.x, z1[j] * rs * bc.y); }
    }
    __syncthreads();
}

__device__ __forceinline__ void router_phase(Frame& F) {
    const int lane = F.lane, wave = F.wave, r = lane & 15, g = lane >> 4;
    const float* x1 = F.out; const float* wrf = (const float*)(F.ws + WS_WRF);
    LAS float* lg = (LAS float*)(F.lds + RING_OFF) + wave * (16 * 48 + 16);
    LAS int* lcnt = (LAS int*)(F.lds + RING_OFF + 32768);
    int* re = (int*)(F.ws + WS_RE); float* rw = (float*)(F.ws + WS_RW); int* rpos = (int*)(F.ws + WS_RPOS); float* rs2 = (float*)(F.ws + WS_RS2);
    const int NGW = F.G * NWAVES;
    for (int wt0 = 0; wt0 < M / 16; wt0 += NGW) {
        const int wt = wt0 + F.vcu * NWAVES + wave; const bool live = wt < M / 16;
        if (F.tid < 32) lcnt[F.tid] = 0;
        __syncthreads();
        int e1 = 0, e2 = 0, r1 = 0, r2 = 0; float w1 = 0.f, w2 = 0.f, rsv = 0.f;
        if (live) {
            const float* xr = x1 + (size_t)(16 * wt + r) * D + 4 * g;
            f32x4 acc[3]; acc[0] = (f32x4){0.f, 0.f, 0.f, 0.f}; acc[1] = acc[0]; acc[2] = acc[0]; float ss = 0.f;
#pragma unroll 4
            for (int i = 0; i < 64; ++i) { const f32x4 a = *(const f32x4*)(xr + 16 * i); ss += (a[0] * a[0] + a[1] * a[1]) + (a[2] * a[2] + a[3] * a[3]);
#pragma unroll
                for (int nt = 0; nt < 3; ++nt) { const f32x4 bw = *(const f32x4*)(wrf + ((size_t)(i * 3 + nt) * 64 + lane) * 4);
#pragma unroll
                    for (int t = 0; t < 4; ++t) acc[nt] = __builtin_amdgcn_mfma_f32_16x16x4f32(a[t], bw[t], acc[nt], 0, 0, 0); } }
            ss += __shfl_xor(ss, 16); ss += __shfl_xor(ss, 32);
            const float rs = __builtin_amdgcn_rsqf(ss * (1.f / D) + EPS);
#pragma unroll
            for (int nt = 0; nt < 3; ++nt)
#pragma unroll
                for (int q = 0; q < 4; ++q) lg[(4 * g + q) * 48 + 16 * nt + r] = acc[nt][q];
            if (g == 0) lg[16 * 48 + r] = rs;
            LDS_WAIT();
            if (lane < 16) {
                const LAS float* l = lg + lane * 48; rsv = lg[16 * 48 + lane];
                float gl[4]; int gi = 0; float gm;
#pragma unroll
                for (int q = 0; q < 4; ++q) gl[q] = l[q] * rsv + kin(I_BGROUP)[q];
                gm = gl[0];
#pragma unroll
                for (int q = 1; q < 4; ++q) if (gl[q] > gm) { gm = gl[q]; gi = q; }
                float den = 0.f;
#pragma unroll
                for (int q = 0; q < 4; ++q) den += __expf(gl[q] - gm);
                const float gw = 1.0f / den;
                float el[8];
#pragma unroll
                for (int q = 0; q < 8; ++q) el[q] = l[4 + 8 * gi + q] * rsv + kin(I_BER)[gi * 8 + q];
                int i1 = 0; float v1 = el[0];
#pragma unroll
                for (int q = 1; q < 8; ++q) if (el[q] > v1) { v1 = el[q]; i1 = q; }
                int i2 = -1; float v2 = -INFINITY;
#pragma unroll
                for (int q = 0; q < 8; ++q) if (q != i1 && el[q] > v2) { v2 = el[q]; i2 = q; }
                const float ex = __expf(v2 - v1); w1 = gw / (1.0f + ex); w2 = gw * ex / (1.0f + ex);
                e1 = gi * 8 + i1; e2 = gi * 8 + i2;
                r1 = atomicAdd((int*)&lcnt[e1], 1); r2 = atomicAdd((int*)&lcnt[e2], 1);
            }
        }
        __syncthreads();
        if (F.tid < 32) { const int c = lcnt[F.tid]; int base = 0; if (c > 0) base = (int)__hip_atomic_fetch_add((unsigned*)(F.ctl + CW_CNT + 64 * F.tid), (unsigned)c, RLX_AGENT); lcnt[32 + F.tid] = base; }
        __syncthreads();
        if (live && lane < 16) { const int tk = 16 * wt + lane;
            re[tk * 2] = e1; re[tk * 2 + 1] = e2; rw[tk * 2] = w1; rw[tk * 2 + 1] = w2; rpos[tk * 2] = lcnt[32 + e1] + r1; rpos[tk * 2 + 1] = lcnt[32 + e2] + r2; rs2[tk] = rsv; }
        __syncthreads();
    }
}
__device__ __forceinline__ int moe_tiles(Frame& F) {
    LAS int* texp = (LAS int*)(F.lds + MISC_OFF + 4096); LAS int* tb = (LAS int*)(F.lds + MISC_OFF + 6144);
    if (F.tid == 0) { int acc = 0; for (int e = 0; e < NE; ++e) { tb[e] = acc; const int c = (int)__hip_atomic_load((unsigned*)(F.ctl + CW_CNT + 64 * e), RLX_AGENT); acc += (c + 255) >> 8; } tb[NE] = acc; }
    __syncthreads();
    const int nt = __builtin_amdgcn_readfirstlane(tb[NE]);
    for (int t = F.tid; t < nt; t += 512) { int e = 0; for (int q = 1; q < NE; ++q) if (tb[q] <= t) e = q; texp[t] = e; }
    __syncthreads();
    return nt;
}
__device__ __forceinline__ void gather_phase(Frame& F) {
    (void)moe_tiles(F);
    const LAS int* tb = (const LAS int*)(F.lds + MISC_OFF + 6144);
    const int gw = F.vcu * NWAVES + F.wave, NGW = F.G * NWAVES, lane = F.lane;
    const int* re = (const int*)(F.ws + WS_RE); const float* rw = (const float*)(F.ws + WS_RW); const int* rpos = (const int*)(F.ws + WS_RPOS); const float* rs2 = (const float*)(F.ws + WS_RS2);
    const f16* x1h = (const f16*)(F.ws + WS_XN); f16* Xs = (f16*)(F.ws + WS_XS);
    int* mtok = (int*)(F.ws + WS_MTOK); float* mw = (float*)(F.ws + WS_MW); float* mrs = (float*)(F.ws + WS_MRS);
    for (int tk = gw; tk < M; tk += NGW) {
        const u32x4 a = *(const u32x4*)(x1h + (size_t)tk * D + lane * 8), b = *(const u32x4*)(x1h + (size_t)tk * D + 512 + lane * 8);
        const float rs = rs2[tk];
#pragma unroll
        for (int sl = 0; sl < 2; ++sl) { const int e = re[tk * 2 + sl], srow = tb[e] * 256 + rpos[tk * 2 + sl];
            *(u32x4*)(Xs + (size_t)srow * D + lane * 8) = a; *(u32x4*)(Xs + (size_t)srow * D + 512 + lane * 8) = b;
            if (lane == 0) { mtok[srow] = tk * 2 + sl; mw[srow] = rw[tk * 2 + sl]; mrs[srow] = rs; } }
    }
}
__device__ __forceinline__ void combine_phase(Frame& F) {
    const int gw = F.vcu * NWAVES + F.wave, NGW = F.G * NWAVES, lane = F.lane;
    const f16* Y = (const f16*)(F.ws + WS_Y); f16* x2n = (f16*)(F.ws + WS_XN);
    for (int m = gw; m < M; m += NGW) {
        f32x4* xr = (f32x4*)(F.out + (size_t)m * D) + lane;
        const f16x4* y0 = (const f16x4*)(Y + (size_t)m * D) + lane; const f16x4* y1 = (const f16x4*)(Y + ((size_t)M + m) * D) + lane;
        f32x4 v[4]; float s = 0.f;
#pragma unroll
        for (int j = 0; j < 4; ++j) { v[j] = xr[64 * j]; const f16x4 a = y0[64 * j], b = y1[64 * j];
            v[j].x += (float)a[0] + (float)b[0]; v[j].y += (float)a[1] + (float)b[1]; v[j].z += (float)a[2] + (float)b[2]; v[j].w += (float)a[3] + (float)b[3];
            s += (v[j].x * v[j].x + v[j].y * v[j].y) + (v[j].z * v[j].z + v[j].w * v[j].w); xr[64 * j] = v[j]; }
        const float rs = __builtin_amdgcn_rsqf(wave_sum(s) * (1.f / D) + EPS);
        u32x2* o8 = (u32x2*)(x2n + (size_t)m * D) + lane;
#pragma unroll
        for (int j = 0; j < 4; ++j) { u32x2 w; w.x = pkh(v[j].x * rs, v[j].y * rs); w.y = pkh(v[j].z * rs, v[j].w * rs); o8[64 * j] = w; }
    }
}
__device__ __forceinline__ void final_phase(Frame& F) {
    const int gw = F.vcu * NWAVES + F.wave, NGW = F.G * NWAVES, lane = F.lane;
    const float* ssqf = (const float*)(F.ws + WS_SSQF);
    f32x4 gf[4];
#pragma unroll
    for (int j = 0; j < 4; ++j) gf[j] = ((const f32x4*)kin(I_GFINAL))[lane + 64 * j];
    for (int m = gw; m < M; m += NGW) {
        const f32x4* sp = (const f32x4*)(ssqf + (size_t)m * 16); const f32x4 s0 = sp[0], s1 = sp[1], s2 = sp[2], s3 = sp[3];
        const float s = (((s0[0] + s0[1]) + (s0[2] + s0[3])) + ((s1[0] + s1[1]) + (s1[2] + s1[3]))) + (((s2[0] + s2[1]) + (s2[2] + s2[3])) + ((s3[0] + s3[1]) + (s3[2] + s3[3])));
        const float rs = __builtin_amdgcn_rsqf(s * (1.f / D) + EPS);
        f32x4* xr = (f32x4*)(F.out + (size_t)m * D) + lane;
#pragma unroll
        for (int j = 0; j < 4; ++j) { f32x4 v = xr[64 * j]; v = v * rs * gf[j]; xr[64 * j] = v; }
    }
}

#ifndef MK_PER_PHASE
#define MK_PER_PHASE 0
#endif
constexpr int NPHASE = 11;
struct Args { const float* in[24]; float* out; unsigned char* ws; int ph_lo, ph_hi; };
__global__ void __launch_bounds__(NWAVES * 64, 2) fwd_kernel(Args args) {
    extern __shared__ __attribute__((aligned(16))) unsigned char lds[];
    Frame F;
    F.lds = (LAS unsigned char*)lds;
    F.tid = threadIdx.x; F.lane = F.tid & 63; F.wave = __builtin_amdgcn_readfirstlane(F.tid >> 6);
    F.G = gridDim.x; { const int bx = blockIdx.x; F.vcu = (F.G % 8 == 0) ? (bx % 8) * (F.G / 8) + bx / 8 : bx; }
    unsigned char* ws = args.ws; F.ws = ws; F.out = args.out;
    F.ctl = (gu32*)(ws + WS_CTL);
    volatile LAS unsigned* MISC = (volatile LAS unsigned*)(F.lds + MISC_OFF);
    for (int u = F.tid; u < 128; u += NWAVES * 64) MISC[u] = 0u;
    __syncthreads();
    XcdBarrier bar; bar.bar = (unsigned*)(F.ctl + CW_BAR); bar.x = 0; bar.st = nullptr;
    if (!MK_PER_PHASE) bar = xcd_barrier_post((unsigned*)(F.ctl + CW_BAR), MISC + 8);
    const int lo = args.ph_lo, hi = args.ph_hi;
#ifndef PH_MASK
#define PH_MASK 0x7ff
#endif
#define IN(k) (((PH_MASK >> (k)) & 1) && lo <= (k) && (k) < hi)
#define SEAM(k) do { if (lo <= (k) && (k) + 1 < hi) xcd_barrier(bar); } while (0)
    LAS unsigned char* ring = F.lds + RING_OFF; LAS unsigned char* misc = F.lds + MISC_OFF;
#define PHASE_FENCE() do { int t_ = threadIdx.x; asm volatile("" : "+v"(t_) :: "memory"); F.tid = t_; F.lane = t_ & 63; } while (0)

    if (IN(0)) { PHASE_FENCE(); p0_prologue(F); } SEAM(0);

    if (IN(1)) {
        { pg8::Gemm g{(const f16*)(ws + WS_XN), (const f16*)(ws + WS_WIN), D}; pg8::StaticOrder So; So.init(M, NIN, F.G, (int)blockIdx.x);
          pg8::Epi1 E{(f16*)(ws + WS_U), (f16*)(ws + WS_Q), (f16*)(ws + WS_K), (f16*)(ws + WS_V), (const float*)(ws + WS_ROPE), (float*)(ws + WS_KPART)};
          pg8::gemm_phase<pg8::Epi1, pg8::StaticOrder, true>(ring, misc, g, So, E); }
        { pg8::Gemm g{(const f16*)(ws + WS_PH), (const f16*)(ws + WS_WPP), PLE}; pg8::StaticOrder So; So.init(M, D, F.G, (int)blockIdx.x);
          pg8::EpiH E{(f16*)(ws + WS_PP), D};
          pg8::gemm_phase<pg8::EpiH, pg8::StaticOrder, true>(ring, misc, g, So, E); }
    } SEAM(1);

    if (IN(2)) {
        PHASE_FENCE();
        for (int i = 0; i < 4; ++i) {
            const int bh = F.vcu >> 1, s2 = (F.vcu & 1) * 2 + (i >> 1), qb = (i & 1) ? 7 - s2 : s2;
            if (bh < NB * NH)
                att::unit<8>(bh / NH, bh % NH, qb, (const f16*)(ws + WS_Q), (const f16*)(ws + WS_K), (const f16*)(ws + WS_V), (f16*)(ws + WS_MIX), (float*)(ws + WS_SSQA), (const float*)(ws + WS_KPART), (char*)lds + RING_OFF, F.tid);
        }
        PHASE_FENCE();
        conv_phase(F);
    } SEAM(2);

    if (IN(3)) {
        pg8::Gemm g{(const f16*)(ws + WS_MIX), (const f16*)(ws + WS_WOUT), D}; pg8::StaticOrder So; So.init(M, D, F.G, (int)blockIdx.x);
        pg8::Epi2 E{kin(I_X), F.out, (f16*)(ws + WS_XN), (const float*)(ws + WS_SSQA)};
        pg8::gemm_phase<pg8::Epi2, pg8::StaticOrder, true>(ring, misc, g, So, E);
    } SEAM(3);

    if (IN(4)) { PHASE_FENCE(); router_phase(F); } SEAM(4);
    if (IN(5)) { PHASE_FENCE(); gather_phase(F); } SEAM(5);

    if (IN(6)) {
        PHASE_FENCE();
        const int ntl = moe_tiles(F);
        pg8::Gemm g{(const f16*)(ws + WS_XS), (const f16*)(ws + WS_WGU), D};
        pg8::MoeOrder So{ntl, 2, F.G, F.vcu, (const LAS int*)(F.lds + MISC_OFF + 4096)};
        pg8::EpiGU E{(f16*)(ws + WS_HS), (const float*)(ws + WS_MRS), (const float*)(ws + WS_MW)};
        pg8::gemm_phase<pg8::EpiGU, pg8::MoeOrder, true>(ring, misc, g, So, E);
    } SEAM(6);

    if (IN(7)) {
        PHASE_FENCE();
        const int ntl = moe_tiles(F);
        pg8::Gemm g{(const f16*)(ws + WS_HS), (const f16*)(ws + WS_WD), DE};
        pg8::MoeOrder So{ntl, 4, F.G, F.vcu, (const LAS int*)(F.lds + MISC_OFF + 4096)};
        pg8::EpiDN E{(f16*)(ws + WS_Y), (const int*)(ws + WS_MTOK)};
        pg8::gemm_phase<pg8::EpiDN, pg8::MoeOrder, true>(ring, misc, g, So, E);
    } SEAM(7);

    if (IN(8)) { PHASE_FENCE(); combine_phase(F); } SEAM(8);

    if (IN(9)) {
        pg8::Gemm g{(const f16*)(ws + WS_XN), (const f16*)(ws + WS_WPG), D}; pg8::StaticOrder So; So.init(M, D, F.G, (int)blockIdx.x);
        pg8::EpiPLE E{F.out, (const f16*)(ws + WS_PP), kin(I_BPG), (float*)(ws + WS_SSQF)};
        pg8::gemm_phase<pg8::EpiPLE, pg8::StaticOrder, true>(ring, misc, g, So, E);
    } SEAM(9);

    if (IN(10)) { PHASE_FENCE(); final_phase(F); }
#undef IN
#undef SEAM
}

extern "C" void kernel_launch(void* const* d_in, const int* in_sizes, int n_in, void* d_out, int out_size, void* d_ws, size_t ws_size, hipStream_t stream) {
    static int grid = 0;
    if (grid == 0) {
        if (n_in != 24 || in_sizes[0] != M * D || out_size != M * D || ws_size < WS_END) { fprintf(stderr, "kernel_launch: unexpected shapes (n_in %d, in0 %d, out %d, ws %zu); nothing launched\n", n_in, n_in > 0 ? in_sizes[0] : -1, out_size, ws_size); grid = -1; return; }
        int dev = 0, cus = 0, per_cu = 0;
        if (hipGetDevice(&dev) != hipSuccess || hipDeviceGetAttribute(&cus, hipDeviceAttributeMultiprocessorCount, dev) != hipSuccess) { grid = -1; return; }
        if (hipFuncSetAttribute((const void*)fwd_kernel, hipFuncAttributeMaxDynamicSharedMemorySize, LDS_BYTES) != hipSuccess) { fprintf(stderr, "kernel_launch: hipFuncSetAttribute failed\n"); grid = -1; return; }
        if (hipOccupancyMaxActiveBlocksPerMultiprocessor(&per_cu, (const void*)fwd_kernel, NWAVES * 64, LDS_BYTES) != hipSuccess || per_cu < 1) fprintf(stderr, "kernel_launch: occupancy query reports %d\n", per_cu);
        (void)hipGetLastError();
        grid = cus;
        if (grid != 256) fprintf(stderr, "kernel_launch: %d CUs; this kernel is laid out for 256\n", grid);
    }
    if (grid < 0) return;
    (void)hipMemsetAsync((char*)d_ws + WS_CTL, 0, CTL_ZERO_BYTES, stream);
    Args a{};
    for (int i = 0; i < 24; ++i) a.in[i] = (const float*)d_in[i];
    a.out = (float*)d_out; a.ws = (unsigned char*)d_ws;
#if MK_PER_PHASE
    for (int p = 0; p < NPHASE; ++p) { a.ph_lo = p; a.ph_hi = p + 1; hipLaunchKernelGGL(fwd_kernel, dim3(grid), dim3(NWAVES * 64), LDS_BYTES, stream, a); }
#else
    a.ph_lo = 0; a.ph_hi = NPHASE;
    hipLaunchKernelGGL(fwd_kernel, dim3(grid), dim3(NWAVES * 64), LDS_BYTES, stream, a);
#endif
}
```
